# Optimizing an MI355X kernel written in HIP

```python
import math
import jax, jax.numpy as jnp
from jax import lax
import numpy as np

D_MODEL = 1024
BATCH = 8
SEQ = 8192
DEPTH = 1
DEC_BATCH = 2
DEC_SEQ = 16384
PAST_LEN = 128

DA_HEADS = 8
DA_HEAD_DIM = 64
DA_Q = DA_HEADS * 2 * DA_HEAD_DIM
DA_K = DA_HEADS * 2 * DA_HEAD_DIM
DA_V = DA_HEADS * 2 * DA_HEAD_DIM
WG_HEADS = 16
WG_KV_HEADS = 4
WG_HEAD_DIM = 64
WG_Q = WG_HEADS * WG_HEAD_DIM
WG_KV = WG_KV_HEADS * WG_HEAD_DIM
WINDOW = 128
BLOCK = 128
N_BRANCH = 2
GATE_COLS = N_BRANCH * D_MODEL
IN_COLS = DA_Q + DA_K + DA_V + WG_Q + 2 * WG_KV + GATE_COLS
IN_SPLITS = (DA_Q, DA_Q + DA_K, DA_Q + DA_K + DA_V, DA_Q + DA_K + DA_V + WG_Q,
             DA_Q + DA_K + DA_V + WG_Q + WG_KV, DA_Q + DA_K + DA_V + WG_Q + 2 * WG_KV)
D_FF = 4 * D_MODEL
DEEPNORM_ALPHA = (2.0 * DEPTH) ** 0.25
DEEPNORM_BETA = (8.0 * DEPTH) ** -0.25
LN_EPS = 1e-5
NEG_BIG = -1e30

kernel_name = "hybrid_diffattn_windowgqa_encoder"


def alibi_slopes(n_heads):
    return jnp.asarray(2.0 ** (-8.0 * np.arange(1, n_heads + 1) / n_heads), dtype=jnp.float32)


def layer_norm(x, g, b):
    xf = x.astype(jnp.float32)
    mu = jnp.mean(xf, axis=-1, keepdims=True)
    xc = xf - mu
    var = jnp.mean(xc * xc, axis=-1, keepdims=True)
    return (xc * lax.rsqrt(var + LN_EPS) * g.astype(jnp.float32) + b.astype(jnp.float32)).astype(x.dtype)


def diff_attention(q, k, v, lam, lam_init, subln_g):
    B, S, H, _, dh = q.shape
    nb = S // BLOCK
    scale = dh ** -0.5
    slopes = alibi_slopes(H)
    kpos = jnp.arange(S, dtype=jnp.float32)
    qb = q.reshape(B, nb, BLOCK, H, 2, dh).transpose(1, 0, 2, 3, 4, 5)

    def one_block(args):
        i, qi = args
        qpos = (i * BLOCK + jnp.arange(BLOCK)).astype(jnp.float32)
        bias = -slopes[:, None, None] * jnp.abs(qpos[:, None] - kpos[None, :])
        s = jnp.einsum('bqhcd,bkhcd->bchqk', qi, k).astype(jnp.float32) * scale + bias
        p = jax.nn.softmax(s, axis=-1)
        a = p[:, 0] - lam * p[:, 1]
        return jnp.einsum('bhqk,bkhe->bqhe', a.astype(v.dtype), v)

    o = lax.map(one_block, (jnp.arange(nb), qb))
    o = o.transpose(1, 0, 2, 3, 4).reshape(B, S, H, 2 * dh)
    of = o.astype(jnp.float32)
    of = of * lax.rsqrt(jnp.mean(of * of, axis=-1, keepdims=True) + LN_EPS)
    of = of * subln_g.astype(jnp.float32) * (1.0 - lam_init)
    return of.astype(v.dtype).reshape(B, S, H * 2 * dh)


def window_attention(q, k, v, sink):
    B, S, H, dh = q.shape
    G = k.shape[2]
    R = H // G
    nb = S // BLOCK
    scale = dh ** -0.5
    qb = q.reshape(B, nb, BLOCK, G, R, dh)
    pad = ((0, 0), (BLOCK, BLOCK), (0, 0), (0, 0))

    def bands(t):
        tp = jnp.pad(t, pad).reshape(B, nb + 2, BLOCK, G, dh)
        return jnp.concatenate([tp[:, :-2], tp[:, 1:-1], tp[:, 2:]], axis=2)

    kb = bands(k)
    vb = bands(v)
    qi = jnp.arange(BLOCK)
    kj = jnp.arange(3 * BLOCK)
    rel = qi[:, None] - kj[None, :] + BLOCK
    dist = jnp.abs(rel).astype(jnp.float32)
    spos = jnp.arange(nb)[:, None] * BLOCK - BLOCK + kj[None, :]
    valid = (jnp.abs(rel) <= WINDOW)[None] & ((spos >= 0) & (spos < S))[:, None, :]
    slopes = alibi_slopes(H).reshape(G, R)
    s = jnp.einsum('bnqgrd,bnkgd->bngrqk', qb, kb).astype(jnp.float32) * scale
    s = s - slopes[:, :, None, None] * dist
    s = jnp.where(valid[None, :, None, None], s, NEG_BIG)
    sk = sink.astype(jnp.float32).reshape(G, R)[None, None, :, :, None, None]
    m = jnp.maximum(jnp.max(s, axis=-1, keepdims=True), sk)
    e = jnp.exp(s - m)
    p = e / (jnp.sum(e, axis=-1, keepdims=True) + jnp.exp(sk - m))
    o = jnp.einsum('bngrqk,bnkgd->bnqgrd', p.astype(v.dtype), vb)
    return o.reshape(B, S, H * dh)


def encoder_layer(x, l, w_in, b_gate, lam_q1, lam_k1, lam_q2, lam_k2, subln_g, sink_logit,
                  w_br_a, w_br_b, w_out, ln1_g, ln1_b, w_ff1, b_ff1, w_ff2, b_ff2, ln2_g, ln2_b):
    B, S, _ = x.shape
    proj = jnp.einsum('bsd,de->bse', x, w_in)
    da_q, da_k, da_v, wg_q, wg_k, wg_v, g_ab = jnp.split(proj, IN_SPLITS, axis=-1)

    lam_init = 0.8 - 0.6 * math.exp(-0.3 * l)
    lam = (jnp.exp(jnp.sum(lam_q1.astype(jnp.float32) * lam_k1.astype(jnp.float32)))
           - jnp.exp(jnp.sum(lam_q2.astype(jnp.float32) * lam_k2.astype(jnp.float32))) + lam_init)
    o_a = diff_attention(da_q.reshape(B, S, DA_HEADS, 2, DA_HEAD_DIM),
                         da_k.reshape(B, S, DA_HEADS, 2, DA_HEAD_DIM),
                         da_v.reshape(B, S, DA_HEADS, 2 * DA_HEAD_DIM),
                         lam, lam_init, subln_g)

    o_b = window_attention(wg_q.reshape(B, S, WG_HEADS, WG_HEAD_DIM),
                           wg_k.reshape(B, S, WG_KV_HEADS, WG_HEAD_DIM),
                           wg_v.reshape(B, S, WG_KV_HEADS, WG_HEAD_DIM),
                           sink_logit)

    gates = jax.nn.sigmoid(g_ab.astype(jnp.float32) + b_gate.astype(jnp.float32)).astype(x.dtype)
    g_a, g_b = jnp.split(gates, 2, axis=-1)
    merged = g_a * jnp.einsum('bse,ed->bsd', o_a, w_br_a) + g_b * jnp.einsum('bse,ed->bsd', o_b, w_br_b)
    mix = jnp.einsum('bsd,de->bse', merged, w_out)
    x = layer_norm(DEEPNORM_ALPHA * x + mix, ln1_g, ln1_b)

    h = jax.nn.relu(jnp.einsum('bsd,df->bsf', x, w_ff1) + b_ff1)
    f = jnp.einsum('bsf,fd->bsd', h * h, w_ff2) + b_ff2
    return layer_norm(DEEPNORM_ALPHA * x + f, ln2_g, ln2_b)


def setup_inputs(seed: int = 0) -> dict:
    key = jax.random.key(seed)
    ks = jax.random.split(key, 24)
    nrm = jax.random.normal
    f32 = jnp.float32
    col_scale = jnp.concatenate([
        jnp.ones((DA_Q + DA_K,), f32),
        jnp.full((DA_V,), DEEPNORM_BETA, f32),
        jnp.ones((WG_Q + WG_KV,), f32),
        jnp.full((WG_KV,), DEEPNORM_BETA, f32),
        jnp.ones((GATE_COLS,), f32)])
    w_in = nrm(ks[2], (DEPTH, D_MODEL, IN_COLS), f32) * (D_MODEL ** -0.5) * col_scale
    return {
        "x_prompt": nrm(ks[0], (BATCH, SEQ, D_MODEL), f32),
        "x_sample": nrm(ks[1], (DEC_BATCH, DEC_SEQ, D_MODEL), f32),
        "w_in": w_in,
        "b_gate": 0.02 * nrm(ks[3], (DEPTH, GATE_COLS), f32),
        "lam_q1": 0.1 * nrm(ks[4], (DEPTH, DA_HEAD_DIM), f32),
        "lam_k1": 0.1 * nrm(ks[5], (DEPTH, DA_HEAD_DIM), f32),
        "lam_q2": 0.1 * nrm(ks[6], (DEPTH, DA_HEAD_DIM), f32),
        "lam_k2": 0.1 * nrm(ks[7], (DEPTH, DA_HEAD_DIM), f32),
        "subln_g": 1.0 + 0.02 * nrm(ks[8], (DEPTH, 2 * DA_HEAD_DIM), f32),
        "sink_logit": 0.5 * nrm(ks[9], (DEPTH, WG_HEADS), f32),
        "w_br_a": nrm(ks[10], (DEPTH, DA_HEADS * 2 * DA_HEAD_DIM, D_MODEL), f32) * ((DA_HEADS * 2 * DA_HEAD_DIM) ** -0.5) * DEEPNORM_BETA,
        "w_br_b": nrm(ks[11], (DEPTH, WG_Q, D_MODEL), f32) * (WG_Q ** -0.5) * DEEPNORM_BETA,
        "w_out": nrm(ks[12], (DEPTH, D_MODEL, D_MODEL), f32) * (D_MODEL ** -0.5) * DEEPNORM_BETA,
        "ln1_g": 1.0 + 0.02 * nrm(ks[13], (DEPTH, D_MODEL), f32),
        "ln1_b": 0.02 * nrm(ks[14], (DEPTH, D_MODEL), f32),
        "w_ff1": nrm(ks[15], (DEPTH, D_MODEL, D_FF), f32) * (D_MODEL ** -0.5) * DEEPNORM_BETA,
        "b_ff1": 0.02 * nrm(ks[16], (DEPTH, D_FF), f32),
        "w_ff2": nrm(ks[17], (DEPTH, D_FF, D_MODEL), f32) * (D_FF ** -0.5) * DEEPNORM_BETA,
        "b_ff2": 0.02 * nrm(ks[18], (DEPTH, D_MODEL), f32),
        "ln2_g": 1.0 + 0.02 * nrm(ks[19], (DEPTH, D_MODEL), f32),
        "ln2_b": 0.02 * nrm(ks[20], (DEPTH, D_MODEL), f32),
    }


def reference(x_prompt, x_sample, w_in, b_gate, lam_q1, lam_k1, lam_q2, lam_k2, subln_g, sink_logit,
              w_br_a, w_br_b, w_out, ln1_g, ln1_b, w_ff1, b_ff1, w_ff2, b_ff2, ln2_g, ln2_b):
    def run(x):
        for l in range(DEPTH):
            x = encoder_layer(x, l, w_in[l], b_gate[l], lam_q1[l], lam_k1[l], lam_q2[l], lam_k2[l],
                              subln_g[l], sink_logit[l], w_br_a[l], w_br_b[l], w_out[l],
                              ln1_g[l], ln1_b[l], w_ff1[l], b_ff1[l], w_ff2[l], b_ff2[l], ln2_g[l], ln2_b[l])
        return x

    y_prompt = run(x_prompt)
    y_sample = run(x_sample)
    return (y_prompt, y_sample)
```

```cpp
#include <hip/hip_runtime.h>
#include <hip/hip_cooperative_groups.h>
#include <cstdio>
#include <cstdint>
namespace cg = cooperative_groups;

namespace pg8 {
#define PG8_LAS __attribute__((address_space(3)))
typedef unsigned short bf16_t;
typedef short bf16x8 __attribute__((ext_vector_type(8)));
typedef float f32x4 __attribute__((ext_vector_type(4)));
typedef unsigned u32x4 __attribute__((ext_vector_type(4)));
constexpr int BM = 256, BK = 64, HALF = 128, HTB = HALF * BK * 2  , STAGE_BYTES = 8 * HTB, NXCD = 8, WGM = 8;

__host__ __device__ __forceinline__ int lds_byte(int r, int c) { const int st = (r >> 4) * 2 + (c >> 5), rr = r & 15, cc = c & 31, ob = rr * 64 + cc * 2; return st * 1024 + (ob ^ (((ob >> 9) & 1) << 5)); }
__host__ __device__ __forceinline__ void stage_rc(int b, int& R, int& C) { const int st = b / 1024, sb = b % 1024, swz = sb ^ (((sb >> 9) & 1) << 5); R = (st >> 1) * 16 + swz / 64; C = (st & 1) * 32 + (swz % 64) / 2; }
__host__ __device__ __forceinline__ int perm32(int rho) { const int n = rho >> 4, i = rho & 15; return 8 * (i >> 2) + 4 * n + (i & 3); }

struct Unit { int pm, pn; };
struct Gemm { const bf16_t* A; const bf16_t* Bt; int M, N, K, lda, ldb; };

struct StaticOrder {
    int nM, nN, nwg, G, c;
    __host__ __device__ void init(int M, int N, int G_, int c_) { nM = M / BM; nN = N / BM; nwg = nM * nN; G = G_; c = c_; }
    __host__ __device__ bool next(int i, Unit& u) const {
        const long L = (long)i * G + c; if (L >= nwg) return false;
        int wgid = (int)L; { const int q = nwg / NXCD, r = nwg % NXCD, xcd = wgid % NXCD, off = wgid / NXCD; wgid = (xcd < r ? xcd * (q + 1) : r * (q + 1) + (xcd - r) * q) + off; }
        const int nig = WGM * nN, gid = wgid / nig, fm = gid * WGM, gsz = (nM - fm) < WGM ? (nM - fm) : WGM;
        u.pm = fm + ((wgid % nig) % gsz); u.pn = (wgid % nig) / gsz; return true;
    }
    __device__ __forceinline__ void a_ready(const Unit&) const {}
    __device__ __forceinline__ void done(const Unit&) const {}
};

typedef __bf16 bf16x2_t __attribute__((ext_vector_type(2)));
typedef float f32x2_t __attribute__((ext_vector_type(2)));
__device__ __forceinline__ unsigned pk_bf16(float lo, float hi) { f32x2_t v = {lo, hi}; bf16x2_t b = __builtin_convertvector(v, bf16x2_t); return __builtin_bit_cast(unsigned, b); }
__device__ __forceinline__ float bf_lo(unsigned w) { return __uint_as_float(w << 16); }
__device__ __forceinline__ float bf_hi(unsigned w) { return __uint_as_float(w & 0xffff0000u); }
__device__ __forceinline__ u32x4 pack8(const f32x4 a, const f32x4 b) { u32x4 w; w.x = pk_bf16(a[0], a[1]); w.y = pk_bf16(a[2], a[3]); w.z = pk_bf16(b[0], b[1]); w.w = pk_bf16(b[2], b[3]); return w; }
#define PG8_ROWFENCE() asm volatile("" ::: "memory")

struct EpiQKV {
    static constexpr bool PERM = true, AFTER_DRAIN = false;
    bf16_t *PA, *PB, *PC, *PD, *PE, *PF; float qscale;
    __device__ __forceinline__ void operator()(const f32x4 (&acc)[2][2][4][2], const Unit& u, int wr, int wc, int fr, int fq) const {
        const int pn = u.pn; bf16_t* base; int ld = 1024, cb; float sc = 1.f;
        if (pn < 4) { base = PA; cb = pn * 256; sc = qscale; }
        else if (pn < 8) { base = PB; cb = (pn - 4) * 256; }
        else if (pn < 12) { base = PC; cb = (pn - 8) * 256; }
        else if (pn < 16) { base = PD; cb = (pn - 12) * 256; sc = qscale; }
        else if (pn == 16) { base = PE; ld = 256; cb = 0; }
        else { base = PF; ld = 256; cb = 0; }
        const int row0 = u.pm * BM + wr * 64 + fr, col0 = cb + wc * 32 + 8 * fq;
#pragma unroll
        for (int ai = 0; ai < 2; ++ai)
#pragma unroll
            for (int m = 0; m < 4; ++m) { bf16_t* rowp = base + (size_t)(row0 + ai * HALF + m * 16) * ld + col0;
#pragma unroll
                for (int bj = 0; bj < 2; ++bj) *(u32x4*)(rowp + bj * HALF) = pack8(acc[ai][bj][m][0] * sc, acc[ai][bj][m][1] * sc); }
    }
};
struct EpiGate {
    static constexpr bool PERM = true, AFTER_DRAIN = false;
    bf16_t* G; const float* bias;
    __device__ __forceinline__ void operator()(const f32x4 (&acc)[2][2][4][2], const Unit& u, int wr, int wc, int fr, int fq) const {
        const int row0 = u.pm * BM + wr * 64 + fr, col0 = u.pn * BM + wc * 32 + 8 * fq;
        f32x4 bv[2][2];
#pragma unroll
        for (int bj = 0; bj < 2; ++bj)
#pragma unroll
            for (int n = 0; n < 2; ++n) bv[bj][n] = *(const f32x4*)(bias + col0 + bj * HALF + 4 * n);
#pragma unroll
        for (int ai = 0; ai < 2; ++ai)
#pragma unroll
            for (int m = 0; m < 4; ++m) { bf16_t* rowp = G + (size_t)(row0 + ai * HALF + m * 16) * 2048 + col0;
#pragma unroll
                for (int bj = 0; bj < 2; ++bj) { f32x4 v0 = acc[ai][bj][m][0] + bv[bj][0], v1 = acc[ai][bj][m][1] + bv[bj][1];
#pragma unroll
                    for (int e = 0; e < 4; ++e) { v0[e] = __builtin_amdgcn_rcpf(1.f + __expf(-v0[e])); v1[e] = __builtin_amdgcn_rcpf(1.f + __expf(-v1[e])); }
                    *(u32x4*)(rowp + bj * HALF) = pack8(v0, v1); } }
    }
};
template <bool SECOND> struct EpiBranch {
    static constexpr bool PERM = true, AFTER_DRAIN = false;
    bf16_t* G;
    __device__ __forceinline__ void operator()(const f32x4 (&acc)[2][2][4][2], const Unit& u, int wr, int wc, int fr, int fq) const {
        const int row0 = u.pm * BM + wr * 64 + fr, col0 = u.pn * BM + wc * 32 + 8 * fq;
#pragma unroll
        for (int ai = 0; ai < 2; ++ai)
#pragma unroll
            for (int m = 0; m < 4; ++m) { bf16_t* rowp = G + (size_t)(row0 + ai * HALF + m * 16) * 2048 + col0;
#pragma unroll
                for (int bj = 0; bj < 2; ++bj) {
                    const u32x4 gw = *(const u32x4*)(rowp + bj * HALF + (SECOND ? 1024 : 0));
                    const f32x4 a0 = acc[ai][bj][m][0], a1 = acc[ai][bj][m][1];
                    f32x4 v0 = {bf_lo(gw.x) * a0[0], bf_hi(gw.x) * a0[1], bf_lo(gw.y) * a0[2], bf_hi(gw.y) * a0[3]};
                    f32x4 v1 = {bf_lo(gw.z) * a1[0], bf_hi(gw.z) * a1[1], bf_lo(gw.w) * a1[2], bf_hi(gw.w) * a1[3]};
                    if (SECOND) { const u32x4 pw = *(const u32x4*)(rowp + bj * HALF);
                        v0 += (f32x4){bf_lo(pw.x), bf_hi(pw.x), bf_lo(pw.y), bf_hi(pw.y)}; v1 += (f32x4){bf_lo(pw.z), bf_hi(pw.z), bf_lo(pw.w), bf_hi(pw.w)}; }
                    *(u32x4*)(rowp + bj * HALF) = pack8(v0, v1); }
                PG8_ROWFENCE(); }
    }
};
struct EpiFF1 {
    static constexpr bool PERM = true, AFTER_DRAIN = false;
    bf16_t* H; const float* bias;
    __device__ __forceinline__ void operator()(const f32x4 (&acc)[2][2][4][2], const Unit& u, int wr, int wc, int fr, int fq) const {
        const int row0 = u.pm * BM + wr * 64 + fr, col0 = u.pn * BM + wc * 32 + 8 * fq;
        f32x4 bv[2][2];
#pragma unroll
        for (int bj = 0; bj < 2; ++bj)
#pragma unroll
            for (int n = 0; n < 2; ++n) bv[bj][n] = *(const f32x4*)(bias + col0 + bj * HALF + 4 * n);
#pragma unroll
        for (int ai = 0; ai < 2; ++ai)
#pragma unroll
            for (int m = 0; m < 4; ++m) { bf16_t* rowp = H + (size_t)(row0 + ai * HALF + m * 16) * 4096 + col0;
#pragma unroll
                for (int bj = 0; bj < 2; ++bj) { f32x4 v0 = acc[ai][bj][m][0] + bv[bj][0], v1 = acc[ai][bj][m][1] + bv[bj][1];
#pragma unroll
                    for (int e = 0; e < 4; ++e) { v0[e] = fmaxf(v0[e], 0.f); v1[e] = fmaxf(v1[e], 0.f); }
                    *(u32x4*)(rowp + bj * HALF) = pack8(v0 * v0, v1 * v1); } }
    }
};
struct EpiRes {
    static constexpr bool PERM = false, AFTER_DRAIN = false;
    const float* resA; const float* resB; int splitRow; float* out; const float* bias; float alpha;
    __device__ __forceinline__ void operator()(const f32x4 (&acc)[2][2][4][2], const Unit& u, int wr, int wc, int fr, int fq) const {
        const int rowt = u.pm * BM; const int col0 = u.pn * BM + wc * 32 + 4 * fq;
        const float* rbase = rowt < splitRow ? resA + (size_t)rowt * 1024 : resB + (size_t)(rowt - splitRow) * 1024;
        float* obase = out + (size_t)rowt * 1024;
        f32x4 bv[2][2];
#pragma unroll
        for (int bj = 0; bj < 2; ++bj)
#pragma unroll
            for (int n = 0; n < 2; ++n) bv[bj][n] = bias ? *(const f32x4*)(bias + col0 + bj * HALF + n * 16) : (f32x4){0.f, 0.f, 0.f, 0.f};
#pragma unroll
        for (int ai = 0; ai < 2; ++ai)
#pragma unroll
            for (int m = 0; m < 4; ++m) { const size_t off = (size_t)(wr * 64 + fr + ai * HALF + m * 16) * 1024 + col0;
#pragma unroll
                for (int bj = 0; bj < 2; ++bj)
#pragma unroll
                    for (int n = 0; n < 2; ++n) { const f32x4 x = *(const f32x4*)(rbase + off + bj * HALF + n * 16);
                        *(f32x4*)(obase + off + bj * HALF + n * 16) = x * alpha + acc[ai][bj][m][n] + bv[bj][n]; }
                PG8_ROWFENCE(); }
    }
};

template <class Epi, class Sched, bool ALIGN_EPI = false, bool SP2 = false>
__device__ __forceinline__ void gemm_phase(PG8_LAS unsigned char* lds, const Gemm g, const Sched& S, const Epi& E) {
    int tid_ = threadIdx.x; asm volatile("" : "+v"(tid_));
    const int tid = tid_, wid = __builtin_amdgcn_readfirstlane(tid >> 6), lane = tid & 63, wr = wid >> 2, wc = wid & 3, fr = lane & 15, fq = lane >> 4;
    const int K = g.K, nt = K / BK;
    unsigned voffA[2], voffB[2];
#pragma unroll
    for (int i = 0; i < 2; ++i) { int R, C; stage_rc(tid * 16 + i * 8192, R, C); const int Rb = Epi::PERM ? ((R & ~31) + perm32(R & 31)) : R;
        voffA[i] = (unsigned)(R * g.lda + C) * 2u; voffB[i] = (unsigned)(Rb * g.ldb + C) * 2u; }
    const size_t kstep = (size_t)(BK * 2);
    const size_t hstepA = (size_t)HALF * g.lda * 2, hstepB = (size_t)HALF * g.ldb * 2;
    const size_t tstepA = 2 * hstepA, tstepB = 2 * hstepB;
    const unsigned ldsw = (unsigned)wid * 1024u;
    const int aoff = lds_byte(wr * 64 + fr, fq * 8), boff = lds_byte(wc * 32 + fr, fq * 8);
#define PG8_SA(b, h) (((b) * 2 + (h)) * HTB)
#define PG8_SB(b, h) ((4 + (b) * 2 + (h)) * HTB)
#define PG8_STAGE(bufoff, gbase, voff) do { _Pragma("unroll") for (int _i = 0; _i < 2; ++_i) \
        __builtin_amdgcn_global_load_lds((const unsigned*)((const char*)(gbase) + (voff)[_i]), (PG8_LAS unsigned*)(lds + (bufoff) + ldsw + _i * 8192), 16, 0, 0); } while (0)
#define PG8_LDA(dst, b, h) do { _Pragma("unroll") for (int m = 0; m < 4; ++m) _Pragma("unroll") for (int k = 0; k < 2; ++k) dst[m][k] = *(const PG8_LAS bf16x8*)(lds + PG8_SA(b, h) + aoff + m * 2048 + k * 1024); } while (0)
#define PG8_LDB(dst, b, h) do { _Pragma("unroll") for (int n = 0; n < 2; ++n) _Pragma("unroll") for (int k = 0; k < 2; ++k) dst[n][k] = *(const PG8_LAS bf16x8*)(lds + PG8_SB(b, h) + boff + n * 2048 + k * 1024); } while (0)
#define PG8_MMA(ai, bj, At, Bt) do { __builtin_amdgcn_s_setprio(1); _Pragma("unroll") for (int m = 0; m < 4; ++m) _Pragma("unroll") for (int n = 0; n < 2; ++n) _Pragma("unroll") for (int k = 0; k < 2; ++k) \
        acc[ai][bj][m][n] = __builtin_amdgcn_mfma_f32_16x16x32_bf16(Bt[n][k], At[m][k], acc[ai][bj][m][n], 0, 0, 0); __builtin_amdgcn_s_setprio(0); } while (0)
#define PG8_WAIT_V(n) asm volatile("s_waitcnt vmcnt(" #n ")" ::: "memory")
#define PG8_WAIT_L(n) asm volatile("s_waitcnt lgkmcnt(" #n ")" ::: "memory")
#define PG8_BAR __builtin_amdgcn_s_barrier()
#define PG8_SCHED __builtin_amdgcn_sched_barrier(0)
    Unit cur, nxt; int ui = 0;
    if (!S.next(0, cur)) return;
    f32x4 acc[2][2][4][2];
#pragma unroll
    for (int a = 0; a < 2; ++a)
#pragma unroll
        for (int b = 0; b < 2; ++b)
#pragma unroll
            for (int m = 0; m < 4; ++m)
#pragma unroll
                for (int n = 0; n < 2; ++n) acc[a][b][m][n] = (f32x4){0.f, 0.f, 0.f, 0.f};
    bf16x8 At[4][2], B0[2][2], B1[2][2];
    const char* cA = (const char*)g.A + (size_t)cur.pm * tstepA; const char* cB = (const char*)g.Bt + (size_t)cur.pn * tstepB;
    S.a_ready(cur);
    if constexpr (SP2) {
        PG8_STAGE(PG8_SB(0, 0), cB, voffB); PG8_STAGE(PG8_SB(0, 1), cB + hstepB, voffB); PG8_STAGE(PG8_SA(0, 0), cA, voffA); PG8_STAGE(PG8_SA(0, 1), cA + hstepA, voffA);
        if (wr == 1) PG8_BAR;
        PG8_WAIT_V(2); PG8_BAR;
        PG8_STAGE(PG8_SB(1, 0), cB + kstep, voffB); PG8_STAGE(PG8_SA(1, 0), cA + kstep, voffA); PG8_STAGE(PG8_SB(1, 1), cB + hstepB + kstep, voffB);
        PG8_WAIT_V(6); PG8_BAR;
    } else {
        PG8_STAGE(PG8_SB(0, 0), cB, voffB); PG8_STAGE(PG8_SA(0, 0), cA, voffA); PG8_STAGE(PG8_SB(0, 1), cB + hstepB, voffB); PG8_STAGE(PG8_SA(0, 1), cA + hstepA, voffA);
        if (wr == 1) PG8_BAR;
        PG8_WAIT_V(4); PG8_BAR;
        PG8_STAGE(PG8_SB(1, 0), cB + kstep, voffB); PG8_STAGE(PG8_SA(1, 0), cA + kstep, voffA); PG8_STAGE(PG8_SB(1, 1), cB + hstepB + kstep, voffB);
        PG8_WAIT_V(6); PG8_BAR;
    }
    for (;;) {
        const bool has_next = S.next(ui + 1, nxt);
        const char* nA = has_next ? (const char*)g.A + (size_t)nxt.pm * tstepA : cA; const char* nB = has_next ? (const char*)g.Bt + (size_t)nxt.pn * tstepB : cB;
        for (int t = 0; t < nt; t += 2) {
            const bool last = (t == nt - 2);
            const char* a1 = cA + (size_t)(t + 1) * kstep;
            const char* a2 = last ? nA : cA + (size_t)(t + 2) * kstep; const char* b2 = last ? nB : cB + (size_t)(t + 2) * kstep;
            const char* a3 = a2 + kstep; const char* b3 = b2 + kstep;
            if (last && has_next) S.a_ready(nxt);
            if constexpr (SP2) {
            PG8_LDB(B0, 0, 0); PG8_LDB(B1, 0, 1); PG8_SCHED; PG8_LDA(At, 0, 0); PG8_STAGE(PG8_SA(1, 1), a1 + hstepA, voffA);
            PG8_WAIT_V(8); PG8_WAIT_L(0); PG8_BAR; PG8_MMA(0, 0, At, B0); PG8_MMA(0, 1, At, B1); PG8_BAR; PG8_SCHED;
            PG8_LDA(At, 0, 1); PG8_STAGE(PG8_SB(0, 0), b2, voffB); PG8_STAGE(PG8_SB(0, 1), b2 + hstepB, voffB); PG8_STAGE(PG8_SA(0, 0), a2, voffA);
            PG8_WAIT_V(8); PG8_WAIT_L(0); PG8_BAR; PG8_MMA(1, 0, At, B0); PG8_MMA(1, 1, At, B1); PG8_BAR; PG8_SCHED;
            PG8_LDB(B0, 1, 0); PG8_LDB(B1, 1, 1); PG8_SCHED; PG8_LDA(At, 1, 0); PG8_STAGE(PG8_SA(0, 1), a2 + hstepA, voffA);
            PG8_WAIT_V(8); PG8_WAIT_L(0); PG8_BAR; PG8_MMA(0, 0, At, B0); PG8_MMA(0, 1, At, B1); PG8_BAR; PG8_SCHED;
            PG8_LDA(At, 1, 1); PG8_STAGE(PG8_SB(1, 0), b3, voffB); PG8_STAGE(PG8_SB(1, 1), b3 + hstepB, voffB); PG8_STAGE(PG8_SA(1, 0), a3, voffA);
            PG8_WAIT_V(8); PG8_WAIT_L(0); PG8_BAR; PG8_MMA(1, 0, At, B0); PG8_MMA(1, 1, At, B1); PG8_BAR; PG8_SCHED;
            } else {
            PG8_LDB(B0, 0, 0); PG8_SCHED; PG8_LDA(At, 0, 0); PG8_STAGE(PG8_SA(1, 1), a1 + hstepA, voffA);
            PG8_WAIT_L(8); PG8_BAR; PG8_WAIT_L(0); PG8_MMA(0, 0, At, B0); PG8_BAR; PG8_SCHED;
            PG8_LDB(B1, 0, 1); PG8_STAGE(PG8_SB(0, 0), b2, voffB);
            PG8_BAR; PG8_WAIT_L(0); PG8_MMA(0, 1, At, B1); PG8_BAR;
            PG8_LDA(At, 0, 1); PG8_STAGE(PG8_SA(0, 0), a2, voffA);
            PG8_BAR; PG8_WAIT_L(0); PG8_MMA(1, 0, At, B0); PG8_BAR; PG8_SCHED;
            PG8_STAGE(PG8_SB(0, 1), b2 + hstepB, voffB);
            PG8_WAIT_V(6); PG8_BAR; PG8_MMA(1, 1, At, B1); PG8_BAR;
            PG8_LDB(B0, 1, 0); PG8_SCHED; PG8_LDA(At, 1, 0); PG8_STAGE(PG8_SA(0, 1), a2 + hstepA, voffA);
            PG8_WAIT_L(8); PG8_BAR; PG8_WAIT_L(0); PG8_MMA(0, 0, At, B0); PG8_BAR; PG8_SCHED;
            PG8_LDB(B1, 1, 1); PG8_STAGE(PG8_SB(1, 0), b3, voffB);
            PG8_BAR; PG8_WAIT_L(0); PG8_MMA(0, 1, At, B1); PG8_BAR;
            PG8_LDA(At, 1, 1); PG8_STAGE(PG8_SA(1, 0), a3, voffA);
            PG8_BAR; PG8_WAIT_L(0); PG8_MMA(1, 0, At, B0); PG8_BAR; PG8_SCHED;
            PG8_STAGE(PG8_SB(1, 1), b3 + hstepB, voffB);
            PG8_WAIT_V(6); PG8_BAR; PG8_MMA(1, 1, At, B1); PG8_BAR;
            }
        }
        if constexpr (ALIGN_EPI) { if (wr == 0) PG8_BAR; }
        if constexpr (!Epi::AFTER_DRAIN) { E(acc, cur, wr, wc, fr, fq); S.done(cur); }
        if (!has_next) break;
#pragma unroll
        for (int a = 0; a < 2; ++a)
#pragma unroll
            for (int b = 0; b < 2; ++b)
#pragma unroll
                for (int m = 0; m < 4; ++m)
#pragma unroll
                    for (int n = 0; n < 2; ++n) acc[a][b][m][n] = (f32x4){0.f, 0.f, 0.f, 0.f};
        cur = nxt; cA = nA; cB = nB; ++ui;
        if constexpr (ALIGN_EPI) { if (wr == 1) PG8_BAR; }
    }
    PG8_WAIT_V(0);
    if constexpr (!ALIGN_EPI) { if (wr == 0) PG8_BAR; }
    PG8_BAR;
    if constexpr (Epi::AFTER_DRAIN) { E.fused(acc, cur, wr, wc, fr, fq, lds, wid, lane); S.done(cur); }
#undef PG8_SA
#undef PG8_SB
#undef PG8_STAGE
#undef PG8_LDA
#undef PG8_LDB
#undef PG8_MMA
#undef PG8_WAIT_V
#undef PG8_WAIT_L
#undef PG8_BAR
#undef PG8_SCHED
}
}

namespace att {
#define ATT_LAS __attribute__((address_space(3)))
typedef unsigned short bf16_t;
typedef short bf16x8 __attribute__((ext_vector_type(8)));
typedef short s16x4 __attribute__((ext_vector_type(4)));
typedef float f32x16 __attribute__((ext_vector_type(16)));
typedef unsigned u32x4 __attribute__((ext_vector_type(4)));
typedef unsigned u32x2 __attribute__((ext_vector_type(2)));
typedef ATT_LAS unsigned char* ldsp;
constexpr float LOG2E = 1.4426950408889634f;
constexpr float QSCALE = 0.125f * LOG2E;
constexpr float LN_EPS = 1e-5f;
#define ATT_MFMA(a, b, c) __builtin_amdgcn_mfma_f32_32x32x16_bf16((a), (b), (c), 0, 0, 0)
__device__ __forceinline__ s16x4 vtr(ldsp p) { return __builtin_bit_cast(s16x4, __builtin_amdgcn_ds_read_tr16_b64_v4i16((ATT_LAS s16x4*)p)); }
__device__ __forceinline__ bf16x8 pack_frag(const f32x16& x, int s8) {
    u32x4 p; p.x = pg8::pk_bf16(x[s8], x[s8 + 1]); p.y = pg8::pk_bf16(x[s8 + 2], x[s8 + 3]); p.z = pg8::pk_bf16(x[s8 + 4], x[s8 + 5]); p.w = pg8::pk_bf16(x[s8 + 6], x[s8 + 7]);
    return __builtin_bit_cast(bf16x8, p);
}
__device__ __forceinline__ int voff(int key, int ch  ) { return (ch >> 2) * 4096 + (key >> 4) * 1024 + ((key >> 3) & 1) * 512 + (key & 7) * 64 + (ch & 3) * 16; }

constexpr int DKP = 272;
constexpr int DKBUF = 64 * DKP, DVBUF = 64 * 256, DBUF = DKBUF + DVBUF;
constexpr int DXOFF = 2 * DBUF;
constexpr int D_LDS = DXOFF + 65536;

__device__ __forceinline__ void diff_unit(ldsp lds, const bf16_t* Qp, const bf16_t* Kp, const bf16_t* Vp, bf16_t* Op,
                                          long rowbase, int S, int h, int qblk, float lam, const float* __restrict__ subln_g) {
    int tid_ = threadIdx.x; asm volatile("" : "+v"(tid_));
    const int tid = tid_, lane = tid & 63, r = lane & 31, hh = lane >> 5;
    const int wid = __builtin_amdgcn_readfirstlane(tid >> 6), c = wid >> 2, qsub = wid & 3;
    const int q0 = qblk * 128, qpos = q0 + qsub * 32 + r;
    const float nslope2 = -LOG2E * __builtin_amdgcn_exp2f(-(float)(h + 1));
    bf16x8 qf[4];
    { const bf16_t* qptr = Qp + (size_t)(rowbase + qpos) * 1024 + h * 128 + c * 64 + hh * 8;
#pragma unroll
      for (int ks = 0; ks < 4; ++ks) qf[ks] = *(const bf16x8*)(qptr + ks * 16); }
    const int skey = tid >> 4, sch = tid & 15;
    const bf16_t* kg = Kp + (size_t)(rowbase + skey) * 1024 + h * 128 + sch * 8;
    const bf16_t* vg = Vp + (size_t)(rowbase + skey) * 1024 + h * 128 + sch * 8;
    const int kl0 = skey * DKP + sch * 16, kl1 = (skey + 32) * DKP + sch * 16;
    const int vl0 = DKBUF + voff(skey, sch), vl1 = DKBUF + voff(skey + 32, sch);
    const int NT = S / 64;
    u32x4 sk0, sk1, sv0, sv1;
    sk0 = *(const u32x4*)(kg); sk1 = *(const u32x4*)(kg + 32 * 1024); sv0 = *(const u32x4*)(vg); sv1 = *(const u32x4*)(vg + 32 * 1024);
    *(ATT_LAS u32x4*)(lds + kl0) = sk0; *(ATT_LAS u32x4*)(lds + kl1) = sk1; *(ATT_LAS u32x4*)(lds + vl0) = sv0; *(ATT_LAS u32x4*)(lds + vl1) = sv1;
    __syncthreads();
    float m = -1e30f, l = 0.f;
    f32x16 o[4];
#pragma unroll
    for (int eb = 0; eb < 4; ++eb)
#pragma unroll
        for (int i = 0; i < 16; ++i) o[eb][i] = 0.f;
    const int kread = r * DKP + c * 128 + hh * 16;
    const int vread = DKBUF + (4 * hh + ((lane & 15) >> 2)) * 64 + ((lane >> 4) & 1) * 32 + (lane & 3) * 8;
    for (int t = 0; t < NT; ++t) {
        const ldsp cur = lds + (t & 1) * DBUF;
        const bool more = (t + 1 < NT);
        if (more) { const size_t go = (size_t)(t + 1) * 64 * 1024;
            sk0 = *(const u32x4*)(kg + go); sk1 = *(const u32x4*)(kg + go + 32 * 1024); sv0 = *(const u32x4*)(vg + go); sv1 = *(const u32x4*)(vg + go + 32 * 1024); }
        f32x16 s0, s1;
#pragma unroll
        for (int i = 0; i < 16; ++i) { s0[i] = 0.f; s1[i] = 0.f; }
#pragma unroll
        for (int ks = 0; ks < 4; ++ks) {
            const bf16x8 k0 = *(const ATT_LAS bf16x8*)(cur + kread + ks * 32);
            const bf16x8 k1 = *(const ATT_LAS bf16x8*)(cur + kread + 32 * DKP + ks * 32);
            s0 = ATT_MFMA(k0, qf[ks], s0); s1 = ATT_MFMA(k1, qf[ks], s1);
        }
        const float dbase = (float)(t * 64 + 4 * hh - qpos);
        float mx = -1e30f;
#pragma unroll
        for (int i = 0; i < 16; ++i) { const float d0 = dbase + (float)((i & 3) + 8 * (i >> 2));
            s0[i] = __builtin_fmaf(nslope2, __builtin_fabsf(d0), s0[i]); s1[i] = __builtin_fmaf(nslope2, __builtin_fabsf(d0 + 32.f), s1[i]);
            mx = fmaxf(mx, fmaxf(s0[i], s1[i])); }
        mx = fmaxf(mx, __shfl_xor(mx, 32));
        if (__any(mx > m)) { const float mn = fmaxf(m, mx), al = __builtin_amdgcn_exp2f(m - mn); m = mn; l *= al;
#pragma unroll
            for (int eb = 0; eb < 4; ++eb) o[eb] *= al; }
        float rs = 0.f;
#pragma unroll
        for (int i = 0; i < 16; ++i) { s0[i] = __builtin_amdgcn_exp2f(s0[i] - m); s1[i] = __builtin_amdgcn_exp2f(s1[i] - m); rs += s0[i] + s1[i]; }
        l += rs;
        bf16x8 pf[4]; pf[0] = pack_frag(s0, 0); pf[1] = pack_frag(s0, 8); pf[2] = pack_frag(s1, 0); pf[3] = pack_frag(s1, 8);
#pragma unroll
        for (int eb = 0; eb < 4; ++eb)
#pragma unroll
            for (int kk = 0; kk < 4; ++kk) {
                const s16x4 lo = vtr(cur + vread + eb * 4096 + kk * 1024), hi = vtr(cur + vread + eb * 4096 + kk * 1024 + 512);
                const bf16x8 vf = __builtin_shufflevector(lo, hi, 0, 1, 2, 3, 4, 5, 6, 7);
                o[eb] = ATT_MFMA(vf, pf[kk], o[eb]);
            }
        if (more) { const ldsp nx = lds + ((t + 1) & 1) * DBUF;
            *(ATT_LAS u32x4*)(nx + kl0) = sk0; *(ATT_LAS u32x4*)(nx + kl1) = sk1; *(ATT_LAS u32x4*)(nx + vl0) = sv0; *(ATT_LAS u32x4*)(nx + vl1) = sv1; }
        __syncthreads();
    }
    l += __shfl_xor(l, 32);
    const float inv = 1.f / l;
    ATT_LAS float* X = (ATT_LAS float*)(lds + DXOFF) + qsub * 4096 + lane;
    if (c == 1) {
#pragma unroll
        for (int eb = 0; eb < 4; ++eb)
#pragma unroll
            for (int i = 0; i < 16; ++i) X[(eb * 16 + i) * 64] = o[eb][i] * inv;
    }
    __syncthreads();
    if (c == 0) {
        float ss = 0.f;
#pragma unroll
        for (int eb = 0; eb < 4; ++eb)
#pragma unroll
            for (int i = 0; i < 16; ++i) { const float v = o[eb][i] * inv - lam * X[(eb * 16 + i) * 64]; o[eb][i] = v; ss += v * v; }
        ss += __shfl_xor(ss, 32);
        const float rn = 0.8f * __builtin_amdgcn_rsqf(ss * (1.f / 128.f) + LN_EPS);
        bf16_t* orow = Op + (size_t)(rowbase + qpos) * 1024 + h * 128 + 4 * hh;
#pragma unroll
        for (int eb = 0; eb < 4; ++eb)
#pragma unroll
            for (int g4 = 0; g4 < 4; ++g4) { const int e0 = eb * 32 + 8 * g4;
                const float4 gv = *(const float4*)(subln_g + e0 + 4 * hh);
                u32x2 w; w.x = pg8::pk_bf16(o[eb][4 * g4] * rn * gv.x, o[eb][4 * g4 + 1] * rn * gv.y); w.y = pg8::pk_bf16(o[eb][4 * g4 + 2] * rn * gv.z, o[eb][4 * g4 + 3] * rn * gv.w);
                *(u32x2*)(orow + e0) = w; }
    }
}

constexpr int WKP = 144;
constexpr int WKBUF = 64 * WKP, WVBUF = 64 * 128, WBUF = WKBUF + WVBUF;

__device__ __forceinline__ void win_unit(ldsp lds, const bf16_t* Qp, const bf16_t* Kp, const bf16_t* Vp, bf16_t* Op,
                                         long rowbase, int S, int hq, int qblk, const float* __restrict__ sink) {
    int tid_ = threadIdx.x; asm volatile("" : "+v"(tid_));
    const int tid = tid_, lane = tid & 63, r = lane & 31, hh = lane >> 5;
    const int wid = __builtin_amdgcn_readfirstlane(tid >> 6), g = hq >> 2;
    const int q0 = qblk * 256, qw0 = q0 + wid * 32, qpos = qw0 + r;
    const float nslope2 = -LOG2E * __builtin_amdgcn_exp2f(-0.5f * (float)(hq + 1));
    bf16x8 qf[4];
    { const bf16_t* qptr = Qp + (size_t)(rowbase + qpos) * 1024 + hq * 64 + hh * 8;
#pragma unroll
      for (int ks = 0; ks < 4; ++ks) qf[ks] = *(const bf16x8*)(qptr + ks * 16); }
    const int skey = tid >> 3, sch = tid & 7;
    const bf16_t* kg = Kp + (size_t)(rowbase + skey) * 256 + g * 64 + sch * 8;
    const bf16_t* vg = Vp + (size_t)(rowbase + skey) * 256 + g * 64 + sch * 8;
    const int kl = skey * WKP + sch * 16, vl = WKBUF + voff(skey, sch);
    const int NT = S / 64;
    int tlo = q0 / 64 - 2; if (tlo < 0) tlo = 0;
    int thi = q0 / 64 + 5; if (thi > NT - 1) thi = NT - 1;
    u32x4 sk, sv;
    sk = *(const u32x4*)(kg + (size_t)tlo * 64 * 256); sv = *(const u32x4*)(vg + (size_t)tlo * 64 * 256);
    *(ATT_LAS u32x4*)(lds + kl) = sk; *(ATT_LAS u32x4*)(lds + vl) = sv;
    __syncthreads();
    float m = -1e30f, l = 0.f;
    f32x16 o[2];
#pragma unroll
    for (int eb = 0; eb < 2; ++eb)
#pragma unroll
        for (int i = 0; i < 16; ++i) o[eb][i] = 0.f;
    const int kread = r * WKP + hh * 16;
    const int vread = WKBUF + (4 * hh + ((lane & 15) >> 2)) * 64 + ((lane >> 4) & 1) * 32 + (lane & 3) * 8;
    for (int t = tlo; t <= thi; ++t) {
        const int b = (t - tlo) & 1;
        const ldsp cur = lds + b * WBUF;
        const bool more = (t < thi);
        if (more) { const size_t go = (size_t)(t + 1) * 64 * 256; sk = *(const u32x4*)(kg + go); sv = *(const u32x4*)(vg + go); }
        const bool active = (t * 64 + 63 >= qw0 - 128) && (t * 64 <= qw0 + 31 + 128);
        if (active) {
            f32x16 s0, s1;
#pragma unroll
            for (int i = 0; i < 16; ++i) { s0[i] = 0.f; s1[i] = 0.f; }
#pragma unroll
            for (int ks = 0; ks < 4; ++ks) {
                const bf16x8 k0 = *(const ATT_LAS bf16x8*)(cur + kread + ks * 32);
                const bf16x8 k1 = *(const ATT_LAS bf16x8*)(cur + kread + 32 * WKP + ks * 32);
                s0 = ATT_MFMA(k0, qf[ks], s0); s1 = ATT_MFMA(k1, qf[ks], s1);
            }
            const float dbase = (float)(t * 64 + 4 * hh - qpos);
            float mx = -INFINITY;
#pragma unroll
            for (int i = 0; i < 16; ++i) { const float d0 = __builtin_fabsf(dbase + (float)((i & 3) + 8 * (i >> 2))), d1 = __builtin_fabsf(dbase + (float)(32 + (i & 3) + 8 * (i >> 2)));
                s0[i] = d0 <= 128.f ? __builtin_fmaf(nslope2, d0, s0[i]) : -INFINITY; s1[i] = d1 <= 128.f ? __builtin_fmaf(nslope2, d1, s1[i]) : -INFINITY;
                mx = fmaxf(mx, fmaxf(s0[i], s1[i])); }
            mx = fmaxf(mx, __shfl_xor(mx, 32));
            if (__any(mx > m)) { const float mn = fmaxf(m, mx), al = __builtin_amdgcn_exp2f(m - mn); m = mn; l *= al;
#pragma unroll
                for (int eb = 0; eb < 2; ++eb) o[eb] *= al; }
            float rs = 0.f;
#pragma unroll
            for (int i = 0; i < 16; ++i) { s0[i] = __builtin_amdgcn_exp2f(s0[i] - m); s1[i] = __builtin_amdgcn_exp2f(s1[i] - m); rs += s0[i] + s1[i]; }
            l += rs;
            bf16x8 pf[4]; pf[0] = pack_frag(s0, 0); pf[1] = pack_frag(s0, 8); pf[2] = pack_frag(s1, 0); pf[3] = pack_frag(s1, 8);
#pragma unroll
            for (int eb = 0; eb < 2; ++eb)
#pragma unroll
                for (int kk = 0; kk < 4; ++kk) {
                    const s16x4 lo = vtr(cur + vread + eb * 4096 + kk * 1024), hi = vtr(cur + vread + eb * 4096 + kk * 1024 + 512);
                    const bf16x8 vf = __builtin_shufflevector(lo, hi, 0, 1, 2, 3, 4, 5, 6, 7);
                    o[eb] = ATT_MFMA(vf, pf[kk], o[eb]);
                }
        }
        if (more) { const ldsp nx = lds + (b ^ 1) * WBUF; *(ATT_LAS u32x4*)(nx + kl) = sk; *(ATT_LAS u32x4*)(nx + vl) = sv; }
        __syncthreads();
    }
    l += __shfl_xor(l, 32);
    const float sk2 = sink[hq] * LOG2E, mf = fmaxf(m, sk2), sc = __builtin_amdgcn_exp2f(m - mf);
    const float inv = sc / (l * sc + __builtin_amdgcn_exp2f(sk2 - mf));
    bf16_t* orow = Op + (size_t)(rowbase + qpos) * 1024 + hq * 64 + 4 * hh;
#pragma unroll
    for (int eb = 0; eb < 2; ++eb)
#pragma unroll
        for (int g4 = 0; g4 < 4; ++g4) { const int e0 = eb * 32 + 8 * g4;
            u32x2 w; w.x = pg8::pk_bf16(o[eb][4 * g4] * inv, o[eb][4 * g4 + 1] * inv); w.y = pg8::pk_bf16(o[eb][4 * g4 + 2] * inv, o[eb][4 * g4 + 3] * inv);
            *(u32x2*)(orow + e0) = w; }
}
}

#define LAS __attribute__((address_space(3)))
typedef unsigned short bf16;
typedef unsigned v4u __attribute__((ext_vector_type(4)));
typedef float f32x4 __attribute__((ext_vector_type(4)));
constexpr int NWAVES = 8;
constexpr int T_P = 8 * 8192, T_S = 2 * 16384, T_ALL = T_P + T_S;
constexpr int DM = 1024, DFF = 4096, IN_COLS = 6656, QKV_COLS = 4608, GATE_COLS = 2048;
constexpr float DN_ALPHA = 1.189207115002721f;
constexpr float LN_EPS = 1e-5f;
constexpr int LDS_BYTES = 147456;
static_assert(att::D_LDS <= LDS_BYTES && pg8::STAGE_BYTES <= LDS_BYTES, "LDS map");
constexpr size_t WS_WIN = 0;
constexpr size_t WS_WBRA = WS_WIN + (size_t)IN_COLS * DM * 2;
constexpr size_t WS_WBRB = WS_WBRA + (size_t)DM * DM * 2;
constexpr size_t WS_WOUT = WS_WBRB + (size_t)DM * DM * 2;
constexpr size_t WS_WFF1 = WS_WOUT + (size_t)DM * DM * 2;
constexpr size_t WS_WFF2 = WS_WFF1 + (size_t)DFF * DM * 2;
constexpr size_t WS_BIG = WS_WFF2 + (size_t)DFF * DM * 2;
constexpr size_t PLANE = (size_t)T_ALL * DM * 2;
constexpr size_t WS_PA = WS_BIG, WS_PB = WS_PA + PLANE, WS_PC = WS_PB + PLANE, WS_PD = WS_PC + PLANE;
constexpr size_t WS_TAIL = WS_PD + PLANE;
constexpr size_t WS_PE = WS_TAIL, WS_PF = WS_PE + (size_t)T_ALL * 256 * 2;
constexpr size_t WS_END = WS_TAIL + PLANE;

__device__ __forceinline__ unsigned f2bf(float f) { unsigned u = __builtin_bit_cast(unsigned, f); return (u + 0x7fffu + ((u >> 16) & 1u)) >> 16; }
__device__ __forceinline__ unsigned pk2(float lo, float hi) { return f2bf(lo) | (f2bf(hi) << 16); }
__device__ __forceinline__ float wave_sum(float v) {
#pragma unroll
    for (int o = 1; o < 64; o <<= 1) v += __shfl_xor(v, o);
    return v;
}
__device__ __forceinline__ void p0_transpose_item(const float* W, int K, int N, bf16* WT, LAS float* scr, int item, int lane) {
    const int nblk = N / 32, kb = item / nblk, nb = item % nblk, k0 = 64 * kb, n0 = 32 * nb;
#pragma unroll 8
    for (int i = 0; i < 32; ++i) { const int kk = 2 * i + (lane >> 5); scr[kk * 33 + (lane & 31)] = W[(size_t)(k0 + kk) * N + n0 + (lane & 31)]; }
    asm volatile("s_waitcnt lgkmcnt(0)" ::: "memory");
    const int c = lane & 7;
#pragma unroll
    for (int j = 0; j < 4; ++j) { const int n = (lane >> 3) + 8 * j; const LAS float* s = scr + (8 * c) * 33 + n;
        v4u o; o.x = pk2(s[0 * 33], s[1 * 33]); o.y = pk2(s[2 * 33], s[3 * 33]); o.z = pk2(s[4 * 33], s[5 * 33]); o.w = pk2(s[6 * 33], s[7 * 33]);
        *(v4u*)(WT + (size_t)(n0 + n) * K + k0 + 8 * c) = o; }
    asm volatile("s_waitcnt lgkmcnt(0)" ::: "memory");
}
template <bool WITH_BF16> __device__ __forceinline__ void ln_rows(float* Z, bf16* Zb, const float* __restrict__ gam, const float* __restrict__ bet, int gw, int NGW, int lane) {
    f32x4 gv[4], bv[4];
#pragma unroll
    for (int j = 0; j < 4; ++j) { gv[j] = *((const f32x4*)gam + 64 * j + lane); bv[j] = *((const f32x4*)bet + 64 * j + lane); }
    for (int m = gw; m < T_ALL; m += NGW) {
        f32x4* zr = (f32x4*)(Z + (size_t)m * DM) + lane;
        f32x4 v[4]; float s = 0.f;
#pragma unroll
        for (int j = 0; j < 4; ++j) { v[j] = zr[64 * j]; s += (v[j].x + v[j].y) + (v[j].z + v[j].w); }
        const float mean = wave_sum(s) * (1.f / DM); float s2 = 0.f;
#pragma unroll
        for (int j = 0; j < 4; ++j) { v[j] = v[j] - mean; s2 += (v[j].x * v[j].x + v[j].y * v[j].y) + (v[j].z * v[j].z + v[j].w * v[j].w); }
        const float rstd = 1.f / sqrtf(wave_sum(s2) * (1.f / DM) + LN_EPS);
#pragma unroll
        for (int j = 0; j < 4; ++j) { const f32x4 y = v[j] * rstd * gv[j] + bv[j]; zr[64 * j] = y;
            if (WITH_BF16) { unsigned long long* o8 = (unsigned long long*)(Zb + (size_t)m * DM) + lane;
                o8[64 * j] = (unsigned long long)pk2(y.x, y.y) | ((unsigned long long)pk2(y.z, y.w) << 32); } }
    }
}

struct Args { const float* in[21]; float* out; unsigned char* ws; };

__global__ void __launch_bounds__(NWAVES * 64) fwd_megakernel(Args a) {
    extern __shared__ __attribute__((aligned(16))) unsigned char lds_raw[];
    cg::grid_group grid = cg::this_grid();
    LAS unsigned char* lds = (LAS unsigned char*)lds_raw;
    const int tid = threadIdx.x, lane = tid & 63, wave = __builtin_amdgcn_readfirstlane(tid >> 6);
    const int G = gridDim.x, bx = blockIdx.x;
    const int vcu = (G % 8 == 0) ? (bx % 8) * (G / 8) + bx / 8 : bx;
    const int gw = vcu * NWAVES + wave, NGW = G * NWAVES;
    unsigned char* ws = a.ws;
    bf16* WinT = (bf16*)(ws + WS_WIN); bf16* WbraT = (bf16*)(ws + WS_WBRA); bf16* WbrbT = (bf16*)(ws + WS_WBRB); bf16* WoutT = (bf16*)(ws + WS_WOUT);
    bf16* Wff1T = (bf16*)(ws + WS_WFF1); bf16* Wff2T = (bf16*)(ws + WS_WFF2);
    bf16* PA = (bf16*)(ws + WS_PA); bf16* PB = (bf16*)(ws + WS_PB); bf16* PC = (bf16*)(ws + WS_PC); bf16* PD = (bf16*)(ws + WS_PD);
    bf16* PE = (bf16*)(ws + WS_PE); bf16* PF = (bf16*)(ws + WS_PF);
    bf16* GM = PB;
    bf16* HB = PA;
    bf16* X1B = (bf16*)(ws + WS_TAIL);
    bf16* XB = (bf16*)a.out;
    float* OUT = a.out;

    {
        LAS float* scr = (LAS float*)(lds + wave * 16384);
        constexpr int I_IN = (DM / 64) * (IN_COLS / 32), I_SQ = (DM / 64) * (DM / 32), I_F1 = (DM / 64) * (DFF / 32), I_F2 = (DFF / 64) * (DM / 32);
        constexpr int NITEMS = I_IN + 3 * I_SQ + I_F1 + I_F2;
        for (int it = gw; it < NITEMS; it += NGW) {
            int r = it;
            if (r < I_IN) { p0_transpose_item(a.in[2], DM, IN_COLS, WinT, scr, r, lane); continue; } r -= I_IN;
            if (r < I_SQ) { p0_transpose_item(a.in[10], DM, DM, WbraT, scr, r, lane); continue; } r -= I_SQ;
            if (r < I_SQ) { p0_transpose_item(a.in[11], DM, DM, WbrbT, scr, r, lane); continue; } r -= I_SQ;
            if (r < I_SQ) { p0_transpose_item(a.in[12], DM, DM, WoutT, scr, r, lane); continue; } r -= I_SQ;
            if (r < I_F1) { p0_transpose_item(a.in[15], DM, DFF, Wff1T, scr, r, lane); continue; } r -= I_F1;
            p0_transpose_item(a.in[17], DFF, DM, Wff2T, scr, r, lane);
        }
        const size_t n8 = (size_t)T_ALL * DM / 8, np8 = (size_t)T_P * DM / 8;
        for (size_t i = (size_t)vcu * (NWAVES * 64) + tid; i < n8; i += (size_t)G * (NWAVES * 64)) {
            const float* src = i < np8 ? a.in[0] + i * 8 : a.in[1] + (i - np8) * 8;
            const f32x4 v0 = *(const f32x4*)src, v1 = *(const f32x4*)(src + 4);
            v4u o; o.x = pk2(v0.x, v0.y); o.y = pk2(v0.z, v0.w); o.z = pk2(v1.x, v1.y); o.w = pk2(v1.z, v1.w);
            *(v4u*)(XB + i * 8) = o;
        }
    }
    grid.sync();

    {
        pg8::Gemm g{XB, WinT, T_ALL, QKV_COLS, DM, DM, DM}; pg8::StaticOrder S; S.init(T_ALL, QKV_COLS, G, bx);
        pg8::EpiQKV E{PA, PB, PC, PD, PE, PF, att::QSCALE};
        pg8::gemm_phase<pg8::EpiQKV, pg8::StaticOrder, true, true>(lds, g, S, E);
    }
    grid.sync();

    {
        float s1 = 0.f, s2 = 0.f;
        for (int i = 0; i < 64; ++i) { s1 += a.in[4][i] * a.in[5][i]; s2 += a.in[6][i] * a.in[7][i]; }
        const float lam = __expf(s1) - __expf(s2) + 0.2f;
        for (int it = vcu; it < 2 * 8 * 128; it += G) {
            const int b = it / (8 * 128), h = (it / 128) % 8, qb = it % 128;
            att::diff_unit(lds, PA, PB, PC, PA, (long)T_P + (long)b * 16384, 16384, h, qb, lam, a.in[8]);
        }
        for (int it = vcu; it < 8 * 8 * 64; it += G) {
            const int b = it / (8 * 64), h = (it / 64) % 8, qb = it % 64;
            att::diff_unit(lds, PA, PB, PC, PA, (long)b * 8192, 8192, h, qb, lam, a.in[8]);
        }
        for (int it = vcu; it < 6144; it += G) {
            if (it < 4096) { const int b = it / (16 * 32), hq = (it / 32) % 16, qb = it % 32;
                att::win_unit(lds, PD, PE, PF, PD, (long)b * 8192, 8192, hq, qb, a.in[9]); }
            else { const int i2 = it - 4096; const int b = i2 / (16 * 64), hq = (i2 / 64) % 16, qb = i2 % 64;
                att::win_unit(lds, PD, PE, PF, PD, (long)T_P + (long)b * 16384, 16384, hq, qb, a.in[9]); }
        }
    }
    grid.sync();

    {
        pg8::Gemm g{XB, WinT + (size_t)QKV_COLS * DM, T_ALL, GATE_COLS, DM, DM, DM}; pg8::StaticOrder S; S.init(T_ALL, GATE_COLS, G, bx);
        pg8::EpiGate E{GM, a.in[3]};
        pg8::gemm_phase<pg8::EpiGate, pg8::StaticOrder, true, true>(lds, g, S, E);
    }
    grid.sync();

    {
        pg8::Gemm g{PA, WbraT, T_ALL, DM, DM, DM, DM}; pg8::StaticOrder S; S.init(T_ALL, DM, G, bx);
        pg8::EpiBranch<false> E{GM};
        pg8::gemm_phase<pg8::EpiBranch<false>, pg8::StaticOrder, true, true>(lds, g, S, E);
    }
    grid.sync();
    {
        pg8::Gemm g{PD, WbrbT, T_ALL, DM, DM, DM, DM}; pg8::StaticOrder S; S.init(T_ALL, DM, G, bx);
        pg8::EpiBranch<true> E{GM};
        pg8::gemm_phase<pg8::EpiBranch<true>, pg8::StaticOrder, true, true>(lds, g, S, E);
    }
    grid.sync();

    {
        pg8::Gemm g{GM, WoutT, T_ALL, DM, DM, 2048, DM}; pg8::StaticOrder S; S.init(T_ALL, DM, G, bx);
        pg8::EpiRes E{a.in[0], a.in[1], T_P, OUT, nullptr, DN_ALPHA};
        pg8::gemm_phase<pg8::EpiRes, pg8::StaticOrder, true, true>(lds, g, S, E);
    }
    grid.sync();

    ln_rows<true>(OUT, X1B, a.in[13], a.in[14], gw, NGW, lane);
    grid.sync();

    {
        pg8::Gemm g{X1B, Wff1T, T_ALL, DFF, DM, DM, DM}; pg8::StaticOrder S; S.init(T_ALL, DFF, G, bx);
        pg8::EpiFF1 E{HB, a.in[16]};
        pg8::gemm_phase<pg8::EpiFF1, pg8::StaticOrder, true, true>(lds, g, S, E);
    }
    grid.sync();

    {
        pg8::Gemm g{HB, Wff2T, T_ALL, DM, DFF, DFF, DFF}; pg8::StaticOrder S; S.init(T_ALL, DM, G, bx);
        pg8::EpiRes E{OUT, OUT, 1 << 30, OUT, a.in[18], DN_ALPHA};
        pg8::gemm_phase<pg8::EpiRes, pg8::StaticOrder, true, true>(lds, g, S, E);
    }
    grid.sync();

    ln_rows<false>(OUT, nullptr, a.in[19], a.in[20], gw, NGW, lane);
}

extern "C" void kernel_launch(void* const* d_in, const int* in_sizes, int n_in, void* d_out, int out_size, void* d_ws, size_t ws_size, hipStream_t stream) {
    static int grid = 0;
    if (grid == 0) {
        if (n_in != 21 || out_size != T_ALL * DM || ws_size < WS_END) { fprintf(stderr, "kernel_launch: unexpected shapes (n_in %d, out %d, ws %zu < %zu)\n", n_in, out_size, ws_size, (size_t)WS_END); grid = -1; return; }
        int dev = 0, cus = 0, per_cu = 0;
        (void)hipGetDevice(&dev);
        (void)hipDeviceGetAttribute(&cus, hipDeviceAttributeMultiprocessorCount, dev);
        (void)hipFuncSetAttribute((const void*)fwd_megakernel, hipFuncAttributeMaxDynamicSharedMemorySize, LDS_BYTES);
        if (hipOccupancyMaxActiveBlocksPerMultiprocessor(&per_cu, (const void*)fwd_megakernel, NWAVES * 64, LDS_BYTES) != hipSuccess || per_cu < 1) per_cu = 1;
        (void)hipGetLastError();
        if (cus <= 0) cus = 256;
        grid = cus * per_cu;
    }
    if (grid < 0) return;
    Args a{};
    for (int i = 0; i < 21; ++i) a.in[i] = (const float*)d_in[i];
    a.out = (float*)d_out; a.ws = (unsigned char*)d_ws;
    void* args[] = {&a};
    hipError_t e = hipLaunchCooperativeKernel((const void*)fwd_megakernel, dim3(grid), dim3(NWAVES * 64), args, LDS_BYTES, stream);
    if (e != hipSuccess) fprintf(stderr, "cooperative launch failed: %s (grid %d)\n", hipGetErrorString(e), grid);
}
```

```cpp
#include <hip/hip_runtime.h>
#include <hip/hip_cooperative_groups.h>
#include <cstdio>
#include <cstdint>
namespace cg = cooperative_groups;

namespace pg8 {
#define PG8_LAS __attribute__((address_space(3)))
typedef unsigned short bf16_t;
typedef short bf16x8 __attribute__((ext_vector_type(8)));
typedef float f32x4 __attribute__((ext_vector_type(4)));
typedef unsigned u32x4 __attribute__((ext_vector_type(4)));
constexpr int BM = 256, BK = 64, HALF = 128, HTB = HALF * BK * 2  , STAGE_BYTES = 8 * HTB, NXCD = 8, WGM = 8;

__host__ __device__ __forceinline__ int lds_byte(int r, int c) { const int st = (r >> 4) * 2 + (c >> 5), rr = r & 15, cc = c & 31, ob = rr * 64 + cc * 2; return st * 1024 + (ob ^ (((ob >> 9) & 1) << 5)); }
__host__ __device__ __forceinline__ void stage_rc(int b, int& R, int& C) { const int st = b / 1024, sb = b % 1024, swz = sb ^ (((sb >> 9) & 1) << 5); R = (st >> 1) * 16 + swz / 64; C = (st & 1) * 32 + (swz % 64) / 2; }
__host__ __device__ __forceinline__ int perm32(int rho) { const int n = rho >> 4, i = rho & 15; return 8 * (i >> 2) + 4 * n + (i & 3); }

struct Unit { int pm, pn; };
struct Gemm { const bf16_t* A; const bf16_t* Bt; int M, N, K, lda, ldb; };

struct StaticOrder {
    int nM, nN, nwg, G, c;
    __host__ __device__ void init(int M, int N, int G_, int c_) { nM = M / BM; nN = N / BM; nwg = nM * nN; G = G_; c = c_; }
    __host__ __device__ bool next(int i, Unit& u) const {
        const long L = (long)i * G + c; if (L >= nwg) return false;
        int wgid = (int)L; { const int q = nwg / NXCD, r = nwg % NXCD, xcd = wgid % NXCD, off = wgid / NXCD; wgid = (xcd < r ? xcd * (q + 1) : r * (q + 1) + (xcd - r) * q) + off; }
        const int nig = WGM * nN, gid = wgid / nig, fm = gid * WGM, gsz = (nM - fm) < WGM ? (nM - fm) : WGM;
        u.pm = fm + ((wgid % nig) % gsz); u.pn = (wgid % nig) / gsz; return true;
    }
    __device__ __forceinline__ void a_ready(const Unit&) const {}
    __device__ __forceinline__ void done(const Unit&) const {}
};

typedef __bf16 bf16x2_t __attribute__((ext_vector_type(2)));
typedef float f32x2_t __attribute__((ext_vector_type(2)));
__device__ __forceinline__ unsigned pk_bf16(float lo, float hi) { f32x2_t v = {lo, hi}; bf16x2_t b = __builtin_convertvector(v, bf16x2_t); return __builtin_bit_cast(unsigned, b); }
__device__ __forceinline__ float bf_lo(unsigned w) { return __uint_as_float(w << 16); }
__device__ __forceinline__ float bf_hi(unsigned w) { return __uint_as_float(w & 0xffff0000u); }
__device__ __forceinline__ u32x4 pack8(const f32x4 a, const f32x4 b) { u32x4 w; w.x = pk_bf16(a[0], a[1]); w.y = pk_bf16(a[2], a[3]); w.z = pk_bf16(b[0], b[1]); w.w = pk_bf16(b[2], b[3]); return w; }
#define PG8_ROWFENCE() asm volatile("" ::: "memory")

struct EpiQKV {
    static constexpr bool PERM = true, AFTER_DRAIN = false;
    bf16_t *PA, *PB, *PC, *PD, *PE, *PF; float qscale; unsigned* stats;
    __device__ __forceinline__ void operator()(const f32x4 (&acc)[2][2][4][2], const Unit& u, int wr, int wc, int fr, int fq) const {
        const int pn = u.pn; bf16_t* base; int ld = 1024, cb; float sc = 1.f;
        if (pn < 8) {
            const float s0 = pn < 4 ? qscale : 1.f; float rmax[2] = {0.f, 0.f};
#pragma unroll
            for (int ai = 0; ai < 2; ++ai)
#pragma unroll
                for (int m = 0; m < 4; ++m)
#pragma unroll
                    for (int bj = 0; bj < 2; ++bj) { const f32x4 a = acc[ai][bj][m][0] * s0, b = acc[ai][bj][m][1] * s0;
                        float q = (a[0] * a[0] + a[1] * a[1]) + (a[2] * a[2] + a[3] * a[3]) + (b[0] * b[0] + b[1] * b[1]) + (b[2] * b[2] + b[3] * b[3]);
                        q += __shfl_xor(q, 16); q += __shfl_xor(q, 32); rmax[bj] = fmaxf(rmax[bj], q); }
#pragma unroll
            for (int bj = 0; bj < 2; ++bj) { float q = rmax[bj];
                q = fmaxf(q, __shfl_xor(q, 1)); q = fmaxf(q, __shfl_xor(q, 2)); q = fmaxf(q, __shfl_xor(q, 4)); q = fmaxf(q, __shfl_xor(q, 8));
                const int rowt = u.pm * BM, seq = rowt < 65536 ? (rowt >> 13) : 8 + ((rowt - 65536) >> 14);
                if (fr == 0 && fq == 0) atomicMax(stats + (seq * 2 + (pn >> 2)) * 32 + (pn & 3) * 8 + bj * 4 + wc, __float_as_uint(q)); }
        }
        if (pn < 4) { base = PA; cb = pn * 256; sc = qscale; }
        else if (pn < 8) { base = PB; cb = (pn - 4) * 256; }
        else if (pn < 12) { base = PC; cb = (pn - 8) * 256; }
        else if (pn < 16) { base = PD; cb = (pn - 12) * 256; sc = qscale; }
        else if (pn == 16) { base = PE; ld = 256; cb = 0; }
        else { base = PF; ld = 256; cb = 0; }
        const int row0 = u.pm * BM + wr * 64 + fr, col0 = cb + wc * 32 + 8 * fq;
#pragma unroll
        for (int ai = 0; ai < 2; ++ai)
#pragma unroll
            for (int m = 0; m < 4; ++m) { bf16_t* rowp = base + (size_t)(row0 + ai * HALF + m * 16) * ld + col0;
#pragma unroll
                for (int bj = 0; bj < 2; ++bj) *(u32x4*)(rowp + bj * HALF) = pack8(acc[ai][bj][m][0] * sc, acc[ai][bj][m][1] * sc); }
    }
};
struct EpiGate {
    static constexpr bool PERM = true, AFTER_DRAIN = false;
    bf16_t* G; const float* bias;
    __device__ __forceinline__ void operator()(const f32x4 (&acc)[2][2][4][2], const Unit& u, int wr, int wc, int fr, int fq) const {
        const int row0 = u.pm * BM + wr * 64 + fr, col0 = u.pn * BM + wc * 32 + 8 * fq;
        f32x4 bv[2][2];
#pragma unroll
        for (int bj = 0; bj < 2; ++bj)
#pragma unroll
            for (int n = 0; n < 2; ++n) bv[bj][n] = *(const f32x4*)(bias + col0 + bj * HALF + 4 * n);
#pragma unroll
        for (int ai = 0; ai < 2; ++ai)
#pragma unroll
            for (int m = 0; m < 4; ++m) { bf16_t* rowp = G + (size_t)(row0 + ai * HALF + m * 16) * 2048 + col0;
#pragma unroll
                for (int bj = 0; bj < 2; ++bj) { f32x4 v0 = acc[ai][bj][m][0] + bv[bj][0], v1 = acc[ai][bj][m][1] + bv[bj][1];
#pragma unroll
                    for (int e = 0; e < 4; ++e) { v0[e] = __builtin_amdgcn_rcpf(1.f + __expf(-v0[e])); v1[e] = __builtin_amdgcn_rcpf(1.f + __expf(-v1[e])); }
                    *(u32x4*)(rowp + bj * HALF) = pack8(v0, v1); } }
    }
};
template <bool SECOND> struct EpiBranch {
    static constexpr bool PERM = true, AFTER_DRAIN = false;
    bf16_t* G;
    __device__ __forceinline__ void operator()(const f32x4 (&acc)[2][2][4][2], const Unit& u, int wr, int wc, int fr, int fq) const {
        const int row0 = u.pm * BM + wr * 64 + fr, col0 = u.pn * BM + wc * 32 + 8 * fq;
#pragma unroll
        for (int ai = 0; ai < 2; ++ai)
#pragma unroll
            for (int m = 0; m < 4; ++m) { bf16_t* rowp = G + (size_t)(row0 + ai * HALF + m * 16) * 2048 + col0;
#pragma unroll
                for (int bj = 0; bj < 2; ++bj) {
                    const u32x4 gw = *(const u32x4*)(rowp + bj * HALF + (SECOND ? 1024 : 0));
                    const f32x4 a0 = acc[ai][bj][m][0], a1 = acc[ai][bj][m][1];
                    f32x4 v0 = {bf_lo(gw.x) * a0[0], bf_hi(gw.x) * a0[1], bf_lo(gw.y) * a0[2], bf_hi(gw.y) * a0[3]};
                    f32x4 v1 = {bf_lo(gw.z) * a1[0], bf_hi(gw.z) * a1[1], bf_lo(gw.w) * a1[2], bf_hi(gw.w) * a1[3]};
                    if (SECOND) { const u32x4 pw = *(const u32x4*)(rowp + bj * HALF);
                        v0 += (f32x4){bf_lo(pw.x), bf_hi(pw.x), bf_lo(pw.y), bf_hi(pw.y)}; v1 += (f32x4){bf_lo(pw.z), bf_hi(pw.z), bf_lo(pw.w), bf_hi(pw.w)}; }
                    *(u32x4*)(rowp + bj * HALF) = pack8(v0, v1); }
                PG8_ROWFENCE(); }
    }
};
struct EpiFF1 {
    static constexpr bool PERM = true, AFTER_DRAIN = false;
    bf16_t* H; const float* bias;
    __device__ __forceinline__ void operator()(const f32x4 (&acc)[2][2][4][2], const Unit& u, int wr, int wc, int fr, int fq) const {
        const int row0 = u.pm * BM + wr * 64 + fr, col0 = u.pn * BM + wc * 32 + 8 * fq;
        f32x4 bv[2][2];
#pragma unroll
        for (int bj = 0; bj < 2; ++bj)
#pragma unroll
            for (int n = 0; n < 2; ++n) bv[bj][n] = *(const f32x4*)(bias + col0 + bj * HALF + 4 * n);
#pragma unroll
        for (int ai = 0; ai < 2; ++ai)
#pragma unroll
            for (int m = 0; m < 4; ++m) { bf16_t* rowp = H + (size_t)(row0 + ai * HALF + m * 16) * 4096 + col0;
#pragma unroll
                for (int bj = 0; bj < 2; ++bj) { f32x4 v0 = acc[ai][bj][m][0] + bv[bj][0], v1 = acc[ai][bj][m][1] + bv[bj][1];
#pragma unroll
                    for (int e = 0; e < 4; ++e) { v0[e] = fmaxf(v0[e], 0.f); v1[e] = fmaxf(v1[e], 0.f); }
                    *(u32x4*)(rowp + bj * HALF) = pack8(v0 * v0, v1 * v1); } }
    }
};
struct EpiRes {
    static constexpr bool PERM = false, AFTER_DRAIN = false;
    const float* resA; const float* resB; int splitRow; float* out; const float* bias; float alpha;
    __device__ __forceinline__ void operator()(const f32x4 (&acc)[2][2][4][2], const Unit& u, int wr, int wc, int fr, int fq) const {
        const int rowt = u.pm * BM; const int col0 = u.pn * BM + wc * 32 + 4 * fq;
        const float* rbase = rowt < splitRow ? resA + (size_t)rowt * 1024 : resB + (size_t)(rowt - splitRow) * 1024;
        float* obase = out + (size_t)rowt * 1024;
        f32x4 bv[2][2];
#pragma unroll
        for (int bj = 0; bj < 2; ++bj)
#pragma unroll
            for (int n = 0; n < 2; ++n) bv[bj][n] = bias ? *(const f32x4*)(bias + col0 + bj * HALF + n * 16) : (f32x4){0.f, 0.f, 0.f, 0.f};
#pragma unroll
        for (int ai = 0; ai < 2; ++ai)
#pragma unroll
            for (int m = 0; m < 4; ++m) { const size_t off = (size_t)(wr * 64 + fr + ai * HALF + m * 16) * 1024 + col0;
#pragma unroll
                for (int bj = 0; bj < 2; ++bj)
#pragma unroll
                    for (int n = 0; n < 2; ++n) { const f32x4 x = *(const f32x4*)(rbase + off + bj * HALF + n * 16);
                        *(f32x4*)(obase + off + bj * HALF + n * 16) = x * alpha + acc[ai][bj][m][n] + bv[bj][n]; }
                PG8_ROWFENCE(); }
    }
};

template <class Epi, class Sched, bool ALIGN_EPI = false, bool SP2 = false>
__device__ __forceinline__ void gemm_phase(PG8_LAS unsigned char* lds, const Gemm g, const Sched& S, const Epi& E) {
    int tid_ = threadIdx.x; asm volatile("" : "+v"(tid_));
    const int tid = tid_, wid = __builtin_amdgcn_readfirstlane(tid >> 6), lane = tid & 63, wr = wid >> 2, wc = wid & 3, fr = lane & 15, fq = lane >> 4;
    const int K = g.K, nt = K / BK;
    unsigned voffA[2], voffB[2];
#pragma unroll
    for (int i = 0; i < 2; ++i) { int R, C; stage_rc(tid * 16 + i * 8192, R, C); const int Rb = Epi::PERM ? ((R & ~31) + perm32(R & 31)) : R;
        voffA[i] = (unsigned)(R * g.lda + C) * 2u; voffB[i] = (unsigned)(Rb * g.ldb + C) * 2u; }
    const size_t kstep = (size_t)(BK * 2);
    const size_t hstepA = (size_t)HALF * g.lda * 2, hstepB = (size_t)HALF * g.ldb * 2;
    const size_t tstepA = 2 * hstepA, tstepB = 2 * hstepB;
    const unsigned ldsw = (unsigned)wid * 1024u;
    const int aoff = lds_byte(wr * 64 + fr, fq * 8), boff = lds_byte(wc * 32 + fr, fq * 8);
#define PG8_SA(b, h) (((b) * 2 + (h)) * HTB)
#define PG8_SB(b, h) ((4 + (b) * 2 + (h)) * HTB)
#define PG8_STAGE(bufoff, gbase, voff) do { _Pragma("unroll") for (int _i = 0; _i < 2; ++_i) \
        __builtin_amdgcn_global_load_lds((const unsigned*)((const char*)(gbase) + (voff)[_i]), (PG8_LAS unsigned*)(lds + (bufoff) + ldsw + _i * 8192), 16, 0, 0); } while (0)
#define PG8_LDA(dst, b, h) do { _Pragma("unroll") for (int m = 0; m < 4; ++m) _Pragma("unroll") for (int k = 0; k < 2; ++k) dst[m][k] = *(const PG8_LAS bf16x8*)(lds + PG8_SA(b, h) + aoff + m * 2048 + k * 1024); } while (0)
#define PG8_LDB(dst, b, h) do { _Pragma("unroll") for (int n = 0; n < 2; ++n) _Pragma("unroll") for (int k = 0; k < 2; ++k) dst[n][k] = *(const PG8_LAS bf16x8*)(lds + PG8_SB(b, h) + boff + n * 2048 + k * 1024); } while (0)
#define PG8_MMA(ai, bj, At, Bt) do { __builtin_amdgcn_s_setprio(1); _Pragma("unroll") for (int m = 0; m < 4; ++m) _Pragma("unroll") for (int n = 0; n < 2; ++n) _Pragma("unroll") for (int k = 0; k < 2; ++k) \
        acc[ai][bj][m][n] = __builtin_amdgcn_mfma_f32_16x16x32_bf16(Bt[n][k], At[m][k], acc[ai][bj][m][n], 0, 0, 0); __builtin_amdgcn_s_setprio(0); } while (0)
#define PG8_WAIT_V(n) asm volatile("s_waitcnt vmcnt(" #n ")" ::: "memory")
#define PG8_WAIT_L(n) asm volatile("s_waitcnt lgkmcnt(" #n ")" ::: "memory")
#define PG8_BAR __builtin_amdgcn_s_barrier()
#define PG8_SCHED __builtin_amdgcn_sched_barrier(0)
    Unit cur, nxt; int ui = 0;
    if (!S.next(0, cur)) return;
    f32x4 acc[2][2][4][2];
#pragma unroll
    for (int a = 0; a < 2; ++a)
#pragma unroll
        for (int b = 0; b < 2; ++b)
#pragma unroll
            for (int m = 0; m < 4; ++m)
#pragma unroll
                for (int n = 0; n < 2; ++n) acc[a][b][m][n] = (f32x4){0.f, 0.f, 0.f, 0.f};
    bf16x8 At[4][2], B0[2][2], B1[2][2];
    const char* cA = (const char*)g.A + (size_t)cur.pm * tstepA; const char* cB = (const char*)g.Bt + (size_t)cur.pn * tstepB;
    S.a_ready(cur);
    if constexpr (SP2) {
        PG8_STAGE(PG8_SB(0, 0), cB, voffB); PG8_STAGE(PG8_SB(0, 1), cB + hstepB, voffB); PG8_STAGE(PG8_SA(0, 0), cA, voffA); PG8_STAGE(PG8_SA(0, 1), cA + hstepA, voffA);
        if (wr == 1) PG8_BAR;
        PG8_WAIT_V(2); PG8_BAR;
        PG8_STAGE(PG8_SB(1, 0), cB + kstep, voffB); PG8_STAGE(PG8_SA(1, 0), cA + kstep, voffA); PG8_STAGE(PG8_SB(1, 1), cB + hstepB + kstep, voffB);
        PG8_WAIT_V(6); PG8_BAR;
    } else {
        PG8_STAGE(PG8_SB(0, 0), cB, voffB); PG8_STAGE(PG8_SA(0, 0), cA, voffA); PG8_STAGE(PG8_SB(0, 1), cB + hstepB, voffB); PG8_STAGE(PG8_SA(0, 1), cA + hstepA, voffA);
        if (wr == 1) PG8_BAR;
        PG8_WAIT_V(4); PG8_BAR;
        PG8_STAGE(PG8_SB(1, 0), cB + kstep, voffB); PG8_STAGE(PG8_SA(1, 0), cA + kstep, voffA); PG8_STAGE(PG8_SB(1, 1), cB + hstepB + kstep, voffB);
        PG8_WAIT_V(6); PG8_BAR;
    }
    for (;;) {
        const bool has_next = S.next(ui + 1, nxt);
        const char* nA = has_next ? (const char*)g.A + (size_t)nxt.pm * tstepA : cA; const char* nB = has_next ? (const char*)g.Bt + (size_t)nxt.pn * tstepB : cB;
        for (int t = 0; t < nt; t += 2) {
            const bool last = (t == nt - 2);
            const char* a1 = cA + (size_t)(t + 1) * kstep;
            const char* a2 = last ? nA : cA + (size_t)(t + 2) * kstep; const char* b2 = last ? nB : cB + (size_t)(t + 2) * kstep;
            const char* a3 = a2 + kstep; const char* b3 = b2 + kstep;
            if (last && has_next) S.a_ready(nxt);
            if constexpr (SP2) {
            PG8_LDB(B0, 0, 0); PG8_LDB(B1, 0, 1); PG8_SCHED; PG8_LDA(At, 0, 0); PG8_STAGE(PG8_SA(1, 1), a1 + hstepA, voffA);
            PG8_WAIT_V(8); PG8_WAIT_L(0); PG8_BAR; PG8_MMA(0, 0, At, B0); PG8_MMA(0, 1, At, B1); PG8_BAR; PG8_SCHED;
            PG8_LDA(At, 0, 1); PG8_STAGE(PG8_SB(0, 0), b2, voffB); PG8_STAGE(PG8_SB(0, 1), b2 + hstepB, voffB); PG8_STAGE(PG8_SA(0, 0), a2, voffA);
            PG8_WAIT_V(8); PG8_WAIT_L(0); PG8_BAR; PG8_MMA(1, 0, At, B0); PG8_MMA(1, 1, At, B1); PG8_BAR; PG8_SCHED;
            PG8_LDB(B0, 1, 0); PG8_LDB(B1, 1, 1); PG8_SCHED; PG8_LDA(At, 1, 0); PG8_STAGE(PG8_SA(0, 1), a2 + hstepA, voffA);
            PG8_WAIT_V(8); PG8_WAIT_L(0); PG8_BAR; PG8_MMA(0, 0, At, B0); PG8_MMA(0, 1, At, B1); PG8_BAR; PG8_SCHED;
            PG8_LDA(At, 1, 1); PG8_STAGE(PG8_SB(1, 0), b3, voffB); PG8_STAGE(PG8_SB(1, 1), b3 + hstepB, voffB); PG8_STAGE(PG8_SA(1, 0), a3, voffA);
            PG8_WAIT_V(8); PG8_WAIT_L(0); PG8_BAR; PG8_MMA(1, 0, At, B0); PG8_MMA(1, 1, At, B1); PG8_BAR; PG8_SCHED;
            } else {
            PG8_LDB(B0, 0, 0); PG8_SCHED; PG8_LDA(At, 0, 0); PG8_STAGE(PG8_SA(1, 1), a1 + hstepA, voffA);
            PG8_WAIT_L(8); PG8_BAR; PG8_WAIT_L(0); PG8_MMA(0, 0, At, B0); PG8_BAR; PG8_SCHED;
            PG8_LDB(B1, 0, 1); PG8_STAGE(PG8_SB(0, 0), b2, voffB);
            PG8_BAR; PG8_WAIT_L(0); PG8_MMA(0, 1, At, B1); PG8_BAR;
            PG8_LDA(At, 0, 1); PG8_STAGE(PG8_SA(0, 0), a2, voffA);
            PG8_BAR; PG8_WAIT_L(0); PG8_MMA(1, 0, At, B0); PG8_BAR; PG8_SCHED;
            PG8_STAGE(PG8_SB(0, 1), b2 + hstepB, voffB);
            PG8_WAIT_V(6); PG8_BAR; PG8_MMA(1, 1, At, B1); PG8_BAR;
            PG8_LDB(B0, 1, 0); PG8_SCHED; PG8_LDA(At, 1, 0); PG8_STAGE(PG8_SA(0, 1), a2 + hstepA, voffA);
            PG8_WAIT_L(8); PG8_BAR; PG8_WAIT_L(0); PG8_MMA(0, 0, At, B0); PG8_BAR; PG8_SCHED;
            PG8_LDB(B1, 1, 1); PG8_STAGE(PG8_SB(1, 0), b3, voffB);
            PG8_BAR; PG8_WAIT_L(0); PG8_MMA(0, 1, At, B1); PG8_BAR;
            PG8_LDA(At, 1, 1); PG8_STAGE(PG8_SA(1, 0), a3, voffA);
            PG8_BAR; PG8_WAIT_L(0); PG8_MMA(1, 0, At, B0); PG8_BAR; PG8_SCHED;
            PG8_STAGE(PG8_SB(1, 1), b3 + hstepB, voffB);
            PG8_WAIT_V(6); PG8_BAR; PG8_MMA(1, 1, At, B1); PG8_BAR;
            }
        }
        if constexpr (ALIGN_EPI) { if (wr == 0) PG8_BAR; }
        if constexpr (!Epi::AFTER_DRAIN) { E(acc, cur, wr, wc, fr, fq); S.done(cur); }
        if (!has_next) break;
#pragma unroll
        for (int a = 0; a < 2; ++a)
#pragma unroll
            for (int b = 0; b < 2; ++b)
#pragma unroll
                for (int m = 0; m < 4; ++m)
#pragma unroll
                    for (int n = 0; n < 2; ++n) acc[a][b][m][n] = (f32x4){0.f, 0.f, 0.f, 0.f};
        cur = nxt; cA = nA; cB = nB; ++ui;
        if constexpr (ALIGN_EPI) { if (wr == 1) PG8_BAR; }
    }
    PG8_WAIT_V(0);
    if constexpr (!ALIGN_EPI) { if (wr == 0) PG8_BAR; }
    PG8_BAR;
    if constexpr (Epi::AFTER_DRAIN) { E.fused(acc, cur, wr, wc, fr, fq, lds, wid, lane); S.done(cur); }
#undef PG8_SA
#undef PG8_SB
#undef PG8_STAGE
#undef PG8_LDA
#undef PG8_LDB
#undef PG8_MMA
#undef PG8_WAIT_V
#undef PG8_WAIT_L
#undef PG8_BAR
#undef PG8_SCHED
}
}

namespace att {
#define ATT_LAS __attribute__((address_space(3)))
typedef unsigned short bf16_t;
typedef short bf16x8 __attribute__((ext_vector_type(8)));
typedef short s16x4 __attribute__((ext_vector_type(4)));
typedef float f32x16 __attribute__((ext_vector_type(16)));
typedef unsigned u32x4 __attribute__((ext_vector_type(4)));
typedef unsigned u32x2 __attribute__((ext_vector_type(2)));
typedef ATT_LAS unsigned char* ldsp;
constexpr float LOG2E = 1.4426950408889634f;
constexpr float QSCALE = 0.125f * LOG2E;
constexpr float LN_EPS = 1e-5f;
#define ATT_MFMA(a, b, c) __builtin_amdgcn_mfma_f32_32x32x16_bf16((a), (b), (c), 0, 0, 0)
__device__ __forceinline__ s16x4 vtr(ldsp p) { return __builtin_bit_cast(s16x4, __builtin_amdgcn_ds_read_tr16_b64_v4i16((ATT_LAS s16x4*)p)); }
__device__ __forceinline__ bf16x8 pack_frag(const f32x16& x, int s8) {
    u32x4 p; p.x = pg8::pk_bf16(x[s8], x[s8 + 1]); p.y = pg8::pk_bf16(x[s8 + 2], x[s8 + 3]); p.z = pg8::pk_bf16(x[s8 + 4], x[s8 + 5]); p.w = pg8::pk_bf16(x[s8 + 6], x[s8 + 7]);
    return __builtin_bit_cast(bf16x8, p);
}
__device__ __forceinline__ int voff(int key, int ch  ) { return (ch >> 2) * 4096 + (key >> 4) * 1024 + ((key >> 3) & 1) * 512 + (key & 7) * 64 + (ch & 3) * 16; }

constexpr int DKP = 272;
constexpr int DKBUF = 64 * DKP, DVBUF = 64 * 256, DBUF = DKBUF + DVBUF;
constexpr int DXOFF = 2 * DBUF;
constexpr int D_LDS = DXOFF + 65536;

__device__ __forceinline__ void diff_unit(ldsp lds, const bf16_t* Qp, const bf16_t* Kp, const bf16_t* Vp, bf16_t* Op,
                                          long rowbase, int S, int h, int qblk, float lam, const float* __restrict__ subln_g, const unsigned* stats  ) {
    int tid_ = threadIdx.x; asm volatile("" : "+v"(tid_));
    const int tid = tid_, lane = tid & 63, r = lane & 31, hh = lane >> 5;
    const int wid = __builtin_amdgcn_readfirstlane(tid >> 6), c = wid >> 2, qsub = wid & 3;
    const int q0 = qblk * 128, qpos = q0 + qsub * 32 + r;
    const float nslope2 = -LOG2E * __builtin_amdgcn_exp2f(-(float)(h + 1));
    bf16x8 qf[4];
    { const bf16_t* qptr = Qp + (size_t)(rowbase + qpos) * 1024 + h * 128 + c * 64 + hh * 8;
#pragma unroll
      for (int ks = 0; ks < 4; ++ks) qf[ks] = *(const bf16x8*)(qptr + ks * 16); }
    const int skey = tid >> 4, sch = tid & 15;
    const bf16_t* kg = Kp + (size_t)(rowbase + skey) * 1024 + h * 128 + sch * 8;
    const bf16_t* vg = Vp + (size_t)(rowbase + skey) * 1024 + h * 128 + sch * 8;
    const int kl0 = skey * DKP + sch * 16, kl1 = (skey + 32) * DKP + sch * 16;
    const int vl0 = DKBUF + voff(skey, sch), vl1 = DKBUF + voff(skey + 32, sch);
    const int NT = S / 64;
    int tlo, thi;
    { float b2 = 0.f;
#pragma unroll
      for (int cc = 0; cc < 2; ++cc) { const float qn = __uint_as_float(stats[h * 4 + cc * 2]) + __uint_as_float(stats[h * 4 + cc * 2 + 1]);
          const float kn = __uint_as_float(stats[32 + h * 4 + cc * 2]) + __uint_as_float(stats[32 + h * 4 + cc * 2 + 1]); b2 = fmaxf(b2, qn * kn); }
      const float B = 1.02f * sqrtf(b2);
      float dcf = (150.f + 2.f * B) / (-nslope2) + 2.f; if (!(dcf < (float)S)) dcf = (float)S;
      const int dc = (int)dcf; const int lo = q0 - dc, hi2 = q0 + 127 + dc;
      tlo = lo <= 0 ? 0 : (lo >> 6); thi = (hi2 >> 6) > NT - 1 ? NT - 1 : (hi2 >> 6);
      tlo = __builtin_amdgcn_readfirstlane(tlo); thi = __builtin_amdgcn_readfirstlane(thi); }
    u32x4 sk0, sk1, sv0, sv1;
    { const size_t go = (size_t)tlo * 64 * 1024;
      sk0 = *(const u32x4*)(kg + go); sk1 = *(const u32x4*)(kg + go + 32 * 1024); sv0 = *(const u32x4*)(vg + go); sv1 = *(const u32x4*)(vg + go + 32 * 1024); }
    *(ATT_LAS u32x4*)(lds + kl0) = sk0; *(ATT_LAS u32x4*)(lds + kl1) = sk1; *(ATT_LAS u32x4*)(lds + vl0) = sv0; *(ATT_LAS u32x4*)(lds + vl1) = sv1;
    __syncthreads();
    float m = -1e30f, l = 0.f;
    f32x16 o[4];
#pragma unroll
    for (int eb = 0; eb < 4; ++eb)
#pragma unroll
        for (int i = 0; i < 16; ++i) o[eb][i] = 0.f;
    const int kread = r * DKP + c * 128 + hh * 16;
    const int vread = DKBUF + (4 * hh + ((lane & 15) >> 2)) * 64 + ((lane >> 4) & 1) * 32 + (lane & 3) * 8;
    for (int t = tlo; t <= thi; ++t) {
        const int bsel = (t - tlo) & 1;
        const ldsp cur = lds + bsel * DBUF;
        const bool more = (t < thi);
        if (more) { const size_t go = (size_t)(t + 1) * 64 * 1024;
            sk0 = *(const u32x4*)(kg + go); sk1 = *(const u32x4*)(kg + go + 32 * 1024); sv0 = *(const u32x4*)(vg + go); sv1 = *(const u32x4*)(vg + go + 32 * 1024); }
        f32x16 s0, s1;
#pragma unroll
        for (int i = 0; i < 16; ++i) { s0[i] = 0.f; s1[i] = 0.f; }
#pragma unroll
        for (int ks = 0; ks < 4; ++ks) {
            const bf16x8 k0 = *(const ATT_LAS bf16x8*)(cur + kread + ks * 32);
            const bf16x8 k1 = *(const ATT_LAS bf16x8*)(cur + kread + 32 * DKP + ks * 32);
            s0 = ATT_MFMA(k0, qf[ks], s0); s1 = ATT_MFMA(k1, qf[ks], s1);
        }
        const float dbase = (float)(t * 64 + 4 * hh - qpos);
        float mx = -1e30f;
#pragma unroll
        for (int i = 0; i < 16; ++i) { const float d0 = dbase + (float)((i & 3) + 8 * (i >> 2));
            s0[i] = __builtin_fmaf(nslope2, __builtin_fabsf(d0), s0[i]); s1[i] = __builtin_fmaf(nslope2, __builtin_fabsf(d0 + 32.f), s1[i]);
            mx = fmaxf(mx, fmaxf(s0[i], s1[i])); }
        mx = fmaxf(mx, __shfl_xor(mx, 32));
        if (__any(mx > m)) { const float mn = fmaxf(m, mx), al = __builtin_amdgcn_exp2f(m - mn); m = mn; l *= al;
#pragma unroll
            for (int eb = 0; eb < 4; ++eb) o[eb] *= al; }
        float rs = 0.f;
#pragma unroll
        for (int i = 0; i < 16; ++i) { s0[i] = __builtin_amdgcn_exp2f(s0[i] - m); s1[i] = __builtin_amdgcn_exp2f(s1[i] - m); rs += s0[i] + s1[i]; }
        l += rs;
        bf16x8 pf[4]; pf[0] = pack_frag(s0, 0); pf[1] = pack_frag(s0, 8); pf[2] = pack_frag(s1, 0); pf[3] = pack_frag(s1, 8);
#pragma unroll
        for (int eb = 0; eb < 4; ++eb)
#pragma unroll
            for (int kk = 0; kk < 4; ++kk) {
                const s16x4 lo = vtr(cur + vread + eb * 4096 + kk * 1024), hi = vtr(cur + vread + eb * 4096 + kk * 1024 + 512);
                const bf16x8 vf = __builtin_shufflevector(lo, hi, 0, 1, 2, 3, 4, 5, 6, 7);
                o[eb] = ATT_MFMA(vf, pf[kk], o[eb]);
            }
        if (more) { const ldsp nx = lds + (bsel ^ 1) * DBUF;
            *(ATT_LAS u32x4*)(nx + kl0) = sk0; *(ATT_LAS u32x4*)(nx + kl1) = sk1; *(ATT_LAS u32x4*)(nx + vl0) = sv0; *(ATT_LAS u32x4*)(nx + vl1) = sv1; }
        __syncthreads();
    }
    l += __shfl_xor(l, 32);
    const float inv = 1.f / l;
    ATT_LAS float* X = (ATT_LAS float*)(lds + DXOFF) + qsub * 4096 + lane;
    if (c == 1) {
#pragma unroll
        for (int eb = 0; eb < 4; ++eb)
#pragma unroll
            for (int i = 0; i < 16; ++i) X[(eb * 16 + i) * 64] = o[eb][i] * inv;
    }
    __syncthreads();
    if (c == 0) {
        float ss = 0.f;
#pragma unroll
        for (int eb = 0; eb < 4; ++eb)
#pragma unroll
            for (int i = 0; i < 16; ++i) { const float v = o[eb][i] * inv - lam * X[(eb * 16 + i) * 64]; o[eb][i] = v; ss += v * v; }
        ss += __shfl_xor(ss, 32);
        const float rn = 0.8f * __builtin_amdgcn_rsqf(ss * (1.f / 128.f) + LN_EPS);
        bf16_t* orow = Op + (size_t)(rowbase + qpos) * 1024 + h * 128 + 4 * hh;
#pragma unroll
        for (int eb = 0; eb < 4; ++eb)
#pragma unroll
            for (int g4 = 0; g4 < 4; ++g4) { const int e0 = eb * 32 + 8 * g4;
                const float4 gv = *(const float4*)(subln_g + e0 + 4 * hh);
                u32x2 w; w.x = pg8::pk_bf16(o[eb][4 * g4] * rn * gv.x, o[eb][4 * g4 + 1] * rn * gv.y); w.y = pg8::pk_bf16(o[eb][4 * g4 + 2] * rn * gv.z, o[eb][4 * g4 + 3] * rn * gv.w);
                *(u32x2*)(orow + e0) = w; }
    }
}

constexpr int WKP = 144;
constexpr int WKBUF = 64 * WKP, WVBUF = 64 * 128, WBUF = WKBUF + WVBUF;

__device__ __forceinline__ void win_unit(ldsp lds, const bf16_t* Qp, const bf16_t* Kp, const bf16_t* Vp, bf16_t* Op,
                                         long rowbase, int S, int hq, int qblk, const float* __restrict__ sink) {
    int tid_ = threadIdx.x; asm volatile("" : "+v"(tid_));
    const int tid = tid_, lane = tid & 63, r = lane & 31, hh = lane >> 5;
    const int wid = __builtin_amdgcn_readfirstlane(tid >> 6), g = hq >> 2;
    const int q0 = qblk * 256, qw0 = q0 + wid * 32, qpos = qw0 + r;
    const float nslope2 = -LOG2E * __builtin_amdgcn_exp2f(-0.5f * (float)(hq + 1));
    bf16x8 qf[4];
    { const bf16_t* qptr = Qp + (size_t)(rowbase + qpos) * 1024 + hq * 64 + hh * 8;
#pragma unroll
      for (int ks = 0; ks < 4; ++ks) qf[ks] = *(const bf16x8*)(qptr + ks * 16); }
    const int skey = tid >> 3, sch = tid & 7;
    const bf16_t* kg = Kp + (size_t)(rowbase + skey) * 256 + g * 64 + sch * 8;
    const bf16_t* vg = Vp + (size_t)(rowbase + skey) * 256 + g * 64 + sch * 8;
    const int kl = skey * WKP + sch * 16, vl = WKBUF + voff(skey, sch);
    const int NT = S / 64;
    int tlo = q0 / 64 - 2; if (tlo < 0) tlo = 0;
    int thi = q0 / 64 + 5; if (thi > NT - 1) thi = NT - 1;
    u32x4 sk, sv;
    sk = *(const u32x4*)(kg + (size_t)tlo * 64 * 256); sv = *(const u32x4*)(vg + (size_t)tlo * 64 * 256);
    *(ATT_LAS u32x4*)(lds + kl) = sk; *(ATT_LAS u32x4*)(lds + vl) = sv;
    __syncthreads();
    float m = -1e30f, l = 0.f;
    f32x16 o[2];
#pragma unroll
    for (int eb = 0; eb < 2; ++eb)
#pragma unroll
        for (int i = 0; i < 16; ++i) o[eb][i] = 0.f;
    const int kread = r * WKP + hh * 16;
    const int vread = WKBUF + (4 * hh + ((lane & 15) >> 2)) * 64 + ((lane >> 4) & 1) * 32 + (lane & 3) * 8;
    for (int t = tlo; t <= thi; ++t) {
        const int b = (t - tlo) & 1;
        const ldsp cur = lds + b * WBUF;
        const bool more = (t < thi);
        if (more) { const size_t go = (size_t)(t + 1) * 64 * 256; sk = *(const u32x4*)(kg + go); sv = *(const u32x4*)(vg + go); }
        const bool active = (t * 64 + 63 >= qw0 - 128) && (t * 64 <= qw0 + 31 + 128);
        if (active) {
            f32x16 s0, s1;
#pragma unroll
            for (int i = 0; i < 16; ++i) { s0[i] = 0.f; s1[i] = 0.f; }
#pragma unroll
            for (int ks = 0; ks < 4; ++ks) {
                const bf16x8 k0 = *(const ATT_LAS bf16x8*)(cur + kread + ks * 32);
                const bf16x8 k1 = *(const ATT_LAS bf16x8*)(cur + kread + 32 * WKP + ks * 32);
                s0 = ATT_MFMA(k0, qf[ks], s0); s1 = ATT_MFMA(k1, qf[ks], s1);
            }
            const float dbase = (float)(t * 64 + 4 * hh - qpos);
            float mx = -INFINITY;
#pragma unroll
            for (int i = 0; i < 16; ++i) { const float d0 = __builtin_fabsf(dbase + (float)((i & 3) + 8 * (i >> 2))), d1 = __builtin_fabsf(dbase + (float)(32 + (i & 3) + 8 * (i >> 2)));
                s0[i] = d0 <= 128.f ? __builtin_fmaf(nslope2, d0, s0[i]) : -INFINITY; s1[i] = d1 <= 128.f ? __builtin_fmaf(nslope2, d1, s1[i]) : -INFINITY;
                mx = fmaxf(mx, fmaxf(s0[i], s1[i])); }
            mx = fmaxf(mx, __shfl_xor(mx, 32));
            if (__any(mx > m)) { const float mn = fmaxf(m, mx), al = __builtin_amdgcn_exp2f(m - mn); m = mn; l *= al;
#pragma unroll
                for (int eb = 0; eb < 2; ++eb) o[eb] *= al; }
            float rs = 0.f;
#pragma unroll
            for (int i = 0; i < 16; ++i) { s0[i] = __builtin_amdgcn_exp2f(s0[i] - m); s1[i] = __builtin_amdgcn_exp2f(s1[i] - m); rs += s0[i] + s1[i]; }
            l += rs;
            bf16x8 pf[4]; pf[0] = pack_frag(s0, 0); pf[1] = pack_frag(s0, 8); pf[2] = pack_frag(s1, 0); pf[3] = pack_frag(s1, 8);
#pragma unroll
            for (int eb = 0; eb < 2; ++eb)
#pragma unroll
                for (int kk = 0; kk < 4; ++kk) {
                    const s16x4 lo = vtr(cur + vread + eb * 4096 + kk * 1024), hi = vtr(cur + vread + eb * 4096 + kk * 1024 + 512);
                    const bf16x8 vf = __builtin_shufflevector(lo, hi, 0, 1, 2, 3, 4, 5, 6, 7);
                    o[eb] = ATT_MFMA(vf, pf[kk], o[eb]);
                }
        }
        if (more) { const ldsp nx = lds + (b ^ 1) * WBUF; *(ATT_LAS u32x4*)(nx + kl) = sk; *(ATT_LAS u32x4*)(nx + vl) = sv; }
        __syncthreads();
    }
    l += __shfl_xor(l, 32);
    const float sk2 = sink[hq] * LOG2E, mf = fmaxf(m, sk2), sc = __builtin_amdgcn_exp2f(m - mf);
    const float inv = sc / (l * sc + __builtin_amdgcn_exp2f(sk2 - mf));
    bf16_t* orow = Op + (size_t)(rowbase + qpos) * 1024 + hq * 64 + 4 * hh;
#pragma unroll
    for (int eb = 0; eb < 2; ++eb)
#pragma unroll
        for (int g4 = 0; g4 < 4; ++g4) { const int e0 = eb * 32 + 8 * g4;
            u32x2 w; w.x = pg8::pk_bf16(o[eb][4 * g4] * inv, o[eb][4 * g4 + 1] * inv); w.y = pg8::pk_bf16(o[eb][4 * g4 + 2] * inv, o[eb][4 * g4 + 3] * inv);
            *(u32x2*)(orow + e0) = w; }
}
}

#define LAS __attribute__((address_space(3)))
typedef unsigned short bf16;
typedef unsigned v4u __attribute__((ext_vector_type(4)));
typedef float f32x4 __attribute__((ext_vector_type(4)));
constexpr int NWAVES = 8;
constexpr int T_P = 8 * 8192, T_S = 2 * 16384, T_ALL = T_P + T_S;
constexpr int DM = 1024, DFF = 4096, IN_COLS = 6656, QKV_COLS = 4608, GATE_COLS = 2048;
constexpr float DN_ALPHA = 1.189207115002721f;
constexpr float LN_EPS = 1e-5f;
constexpr int LDS_BYTES = 147456;
static_assert(att::D_LDS <= LDS_BYTES && pg8::STAGE_BYTES <= LDS_BYTES, "LDS map");
constexpr size_t WS_WIN = 0;
constexpr size_t WS_WBRA = WS_WIN + (size_t)IN_COLS * DM * 2;
constexpr size_t WS_WBRB = WS_WBRA + (size_t)DM * DM * 2;
constexpr size_t WS_WOUT = WS_WBRB + (size_t)DM * DM * 2;
constexpr size_t WS_WFF1 = WS_WOUT + (size_t)DM * DM * 2;
constexpr size_t WS_WFF2 = WS_WFF1 + (size_t)DFF * DM * 2;
constexpr size_t WS_BIG = WS_WFF2 + (size_t)DFF * DM * 2;
constexpr size_t PLANE = (size_t)T_ALL * DM * 2;
constexpr size_t WS_PA = WS_BIG, WS_PB = WS_PA + PLANE, WS_PC = WS_PB + PLANE, WS_PD = WS_PC + PLANE;
constexpr size_t WS_TAIL = WS_PD + PLANE;
constexpr size_t WS_PE = WS_TAIL, WS_PF = WS_PE + (size_t)T_ALL * 256 * 2;
constexpr size_t WS_CTL = WS_TAIL + PLANE;
constexpr size_t WS_END = WS_CTL + 8192;
constexpr int LDS_CTL = 135168;
static_assert(att::D_LDS <= LDS_CTL && LDS_CTL + 16 <= 147456, "LDS ctl word");

__device__ __forceinline__ unsigned f2bf(float f) { unsigned u = __builtin_bit_cast(unsigned, f); return (u + 0x7fffu + ((u >> 16) & 1u)) >> 16; }
__device__ __forceinline__ unsigned pk2(float lo, float hi) { return f2bf(lo) | (f2bf(hi) << 16); }
__device__ __forceinline__ float wave_sum(float v) {
#pragma unroll
    for (int o = 1; o < 64; o <<= 1) v += __shfl_xor(v, o);
    return v;
}
__device__ __forceinline__ void p0_transpose_item(const float* W, int K, int N, bf16* WT, LAS float* scr, int item, int lane) {
    const int nblk = N / 32, kb = item / nblk, nb = item % nblk, k0 = 64 * kb, n0 = 32 * nb;
#pragma unroll 8
    for (int i = 0; i < 32; ++i) { const int kk = 2 * i + (lane >> 5); scr[kk * 33 + (lane & 31)] = W[(size_t)(k0 + kk) * N + n0 + (lane & 31)]; }
    asm volatile("s_waitcnt lgkmcnt(0)" ::: "memory");
    const int c = lane & 7;
#pragma unroll
    for (int j = 0; j < 4; ++j) { const int n = (lane >> 3) + 8 * j; const LAS float* s = scr + (8 * c) * 33 + n;
        v4u o; o.x = pk2(s[0 * 33], s[1 * 33]); o.y = pk2(s[2 * 33], s[3 * 33]); o.z = pk2(s[4 * 33], s[5 * 33]); o.w = pk2(s[6 * 33], s[7 * 33]);
        *(v4u*)(WT + (size_t)(n0 + n) * K + k0 + 8 * c) = o; }
    asm volatile("s_waitcnt lgkmcnt(0)" ::: "memory");
}
template <bool WITH_BF16> __device__ __forceinline__ void ln_rows(float* Z, bf16* Zb, const float* __restrict__ gam, const float* __restrict__ bet, int gw, int NGW, int lane) {
    f32x4 gv[4], bv[4];
#pragma unroll
    for (int j = 0; j < 4; ++j) { gv[j] = *((const f32x4*)gam + 64 * j + lane); bv[j] = *((const f32x4*)bet + 64 * j + lane); }
    for (int m = gw; m < T_ALL; m += NGW) {
        f32x4* zr = (f32x4*)(Z + (size_t)m * DM) + lane;
        f32x4 v[4]; float s = 0.f;
#pragma unroll
        for (int j = 0; j < 4; ++j) { v[j] = zr[64 * j]; s += (v[j].x + v[j].y) + (v[j].z + v[j].w); }
        const float mean = wave_sum(s) * (1.f / DM); float s2 = 0.f;
#pragma unroll
        for (int j = 0; j < 4; ++j) { v[j] = v[j] - mean; s2 += (v[j].x * v[j].x + v[j].y * v[j].y) + (v[j].z * v[j].z + v[j].w * v[j].w); }
        const float rstd = 1.f / sqrtf(wave_sum(s2) * (1.f / DM) + LN_EPS);
#pragma unroll
        for (int j = 0; j < 4; ++j) { const f32x4 y = v[j] * rstd * gv[j] + bv[j]; zr[64 * j] = y;
            if (WITH_BF16) { unsigned long long* o8 = (unsigned long long*)(Zb + (size_t)m * DM) + lane;
                o8[64 * j] = (unsigned long long)pk2(y.x, y.y) | ((unsigned long long)pk2(y.z, y.w) << 32); } }
    }
}

struct Args { const float* in[21]; float* out; unsigned char* ws; };

__global__ void __launch_bounds__(NWAVES * 64) fwd_megakernel(Args a) {
    extern __shared__ __attribute__((aligned(16))) unsigned char lds_raw[];
    cg::grid_group grid = cg::this_grid();
    LAS unsigned char* lds = (LAS unsigned char*)lds_raw;
    const int tid = threadIdx.x, lane = tid & 63, wave = __builtin_amdgcn_readfirstlane(tid >> 6);
    const int G = gridDim.x, bx = blockIdx.x;
    const int vcu = (G % 8 == 0) ? (bx % 8) * (G / 8) + bx / 8 : bx;
    const int gw = vcu * NWAVES + wave, NGW = G * NWAVES;
    unsigned char* ws = a.ws;
    bf16* WinT = (bf16*)(ws + WS_WIN); bf16* WbraT = (bf16*)(ws + WS_WBRA); bf16* WbrbT = (bf16*)(ws + WS_WBRB); bf16* WoutT = (bf16*)(ws + WS_WOUT);
    bf16* Wff1T = (bf16*)(ws + WS_WFF1); bf16* Wff2T = (bf16*)(ws + WS_WFF2);
    bf16* PA = (bf16*)(ws + WS_PA); bf16* PB = (bf16*)(ws + WS_PB); bf16* PC = (bf16*)(ws + WS_PC); bf16* PD = (bf16*)(ws + WS_PD);
    bf16* PE = (bf16*)(ws + WS_PE); bf16* PF = (bf16*)(ws + WS_PF);
    bf16* GM = PB;
    bf16* HB = PA;
    bf16* X1B = (bf16*)(ws + WS_TAIL);
    bf16* XB = (bf16*)a.out;
    float* OUT = a.out;

    unsigned* ctl = (unsigned*)(ws + WS_CTL);
    {
        if (bx == 0) for (int i = tid; i < 2048; i += NWAVES * 64) ctl[i] = 0u;
        LAS float* scr = (LAS float*)(lds + wave * 16384);
        constexpr int I_IN = (DM / 64) * (IN_COLS / 32), I_SQ = (DM / 64) * (DM / 32), I_F1 = (DM / 64) * (DFF / 32), I_F2 = (DFF / 64) * (DM / 32);
        constexpr int NITEMS = I_IN + 3 * I_SQ + I_F1 + I_F2;
        for (int it = gw; it < NITEMS; it += NGW) {
            int r = it;
            if (r < I_IN) { p0_transpose_item(a.in[2], DM, IN_COLS, WinT, scr, r, lane); continue; } r -= I_IN;
            if (r < I_SQ) { p0_transpose_item(a.in[10], DM, DM, WbraT, scr, r, lane); continue; } r -= I_SQ;
            if (r < I_SQ) { p0_transpose_item(a.in[11], DM, DM, WbrbT, scr, r, lane); continue; } r -= I_SQ;
            if (r < I_SQ) { p0_transpose_item(a.in[12], DM, DM, WoutT, scr, r, lane); continue; } r -= I_SQ;
            if (r < I_F1) { p0_transpose_item(a.in[15], DM, DFF, Wff1T, scr, r, lane); continue; } r -= I_F1;
            p0_transpose_item(a.in[17], DFF, DM, Wff2T, scr, r, lane);
        }
        const size_t n8 = (size_t)T_ALL * DM / 8, np8 = (size_t)T_P * DM / 8;
        for (size_t i = (size_t)vcu * (NWAVES * 64) + tid; i < n8; i += (size_t)G * (NWAVES * 64)) {
            const float* src = i < np8 ? a.in[0] + i * 8 : a.in[1] + (i - np8) * 8;
            const f32x4 v0 = *(const f32x4*)src, v1 = *(const f32x4*)(src + 4);
            v4u o; o.x = pk2(v0.x, v0.y); o.y = pk2(v0.z, v0.w); o.z = pk2(v1.x, v1.y); o.w = pk2(v1.z, v1.w);
            *(v4u*)(XB + i * 8) = o;
        }
    }
    grid.sync();

    {
        pg8::Gemm g{XB, WinT, T_ALL, QKV_COLS, DM, DM, DM}; pg8::StaticOrder S; S.init(T_ALL, QKV_COLS, G, bx);
        pg8::EpiQKV E{PA, PB, PC, PD, PE, PF, att::QSCALE, ctl};
        pg8::gemm_phase<pg8::EpiQKV, pg8::StaticOrder, true, true>(lds, g, S, E);
    }
    grid.sync();

    {
        float s1 = 0.f, s2 = 0.f;
        for (int i = 0; i < 64; ++i) { s1 += a.in[4][i] * a.in[5][i]; s2 += a.in[6][i] * a.in[7][i]; }
        const float lam = __expf(s1) - __expf(s2) + 0.2f;
        volatile LAS int* bcast = (volatile LAS int*)(lds + LDS_CTL);
        for (int qi = 0; qi < 8; ++qi) {
            const int x = (bx + qi) & 7;
            for (;;) {
                if (tid == 0) bcast[0] = (int)atomicAdd(ctl + 1024 + 64 * x, 1u);
                __syncthreads();
                const int i = __builtin_amdgcn_readfirstlane(bcast[0]);
                __syncthreads();
                if (i >= 768) break;
                const int si = i >> 5, w = i & 31, gi = si / 3, j = si - 3 * gi, h = 7 - gi, cs = (x + h) & 7;
                if (j == 0) { const int b = cs >> 2, part = cs & 3;
                    att::diff_unit(lds, PA, PB, PC, PA, (long)T_P + (long)b * 16384, 16384, h, part * 32 + w, lam, a.in[8], ctl + (8 + b) * 64); }
                else { const int cp = cs + 8 * (j - 1), b = cp >> 1, part = cp & 1;
                    att::diff_unit(lds, PA, PB, PC, PA, (long)b * 8192, 8192, h, part * 32 + w, lam, a.in[8], ctl + b * 64); }
            }
        }
        for (int it = vcu; it < 6144; it += G) {
            if (it < 4096) { const int b = it / (16 * 32), hq = (it / 32) % 16, qb = it % 32;
                att::win_unit(lds, PD, PE, PF, PD, (long)b * 8192, 8192, hq, qb, a.in[9]); }
            else { const int i2 = it - 4096; const int b = i2 / (16 * 64), hq = (i2 / 64) % 16, qb = i2 % 64;
                att::win_unit(lds, PD, PE, PF, PD, (long)T_P + (long)b * 16384, 16384, hq, qb, a.in[9]); }
        }
    }
    grid.sync();

    {
        pg8::Gemm g{XB, WinT + (size_t)QKV_COLS * DM, T_ALL, GATE_COLS, DM, DM, DM}; pg8::StaticOrder S; S.init(T_ALL, GATE_COLS, G, bx);
        pg8::EpiGate E{GM, a.in[3]};
        pg8::gemm_phase<pg8::EpiGate, pg8::StaticOrder, true, true>(lds, g, S, E);
    }
    grid.sync();

    {
        pg8::Gemm g{PA, WbraT, T_ALL, DM, DM, DM, DM}; pg8::StaticOrder S; S.init(T_ALL, DM, G, bx);
        pg8::EpiBranch<false> E{GM};
        pg8::gemm_phase<pg8::EpiBranch<false>, pg8::StaticOrder, true, true>(lds, g, S, E);
    }
    grid.sync();
    {
        pg8::Gemm g{PD, WbrbT, T_ALL, DM, DM, DM, DM}; pg8::StaticOrder S; S.init(T_ALL, DM, G, bx);
        pg8::EpiBranch<true> E{GM};
        pg8::gemm_phase<pg8::EpiBranch<true>, pg8::StaticOrder, true, true>(lds, g, S, E);
    }
    grid.sync();

    {
        pg8::Gemm g{GM, WoutT, T_ALL, DM, DM, 2048, DM}; pg8::StaticOrder S; S.init(T_ALL, DM, G, bx);
        pg8::EpiRes E{a.in[0], a.in[1], T_P, OUT, nullptr, DN_ALPHA};
        pg8::gemm_phase<pg8::EpiRes, pg8::StaticOrder, true, true>(lds, g, S, E);
    }
    grid.sync();

    ln_rows<true>(OUT, X1B, a.in[13], a.in[14], gw, NGW, lane);
    grid.sync();

    {
        pg8::Gemm g{X1B, Wff1T, T_ALL, DFF, DM, DM, DM}; pg8::StaticOrder S; S.init(T_ALL, DFF, G, bx);
        pg8::EpiFF1 E{HB, a.in[16]};
        pg8::gemm_phase<pg8::EpiFF1, pg8::StaticOrder, true, true>(lds, g, S, E);
    }
    grid.sync();

    {
        pg8::Gemm g{HB, Wff2T, T_ALL, DM, DFF, DFF, DFF}; pg8::StaticOrder S; S.init(T_ALL, DM, G, bx);
        pg8::EpiRes E{OUT, OUT, 1 << 30, OUT, a.in[18], DN_ALPHA};
        pg8::gemm_phase<pg8::EpiRes, pg8::StaticOrder, true, true>(lds, g, S, E);
    }
    grid.sync();

    ln_rows<false>(OUT, nullptr, a.in[19], a.in[20], gw, NGW, lane);
}

extern "C" void kernel_launch(void* const* d_in, const int* in_sizes, int n_in, void* d_out, int out_size, void* d_ws, size_t ws_size, hipStream_t stream) {
    static int grid = 0;
    if (grid == 0) {
        if (n_in != 21 || out_size != T_ALL * DM || ws_size < WS_END) { fprintf(stderr, "kernel_launch: unexpected shapes (n_in %d, out %d, ws %zu < %zu)\n", n_in, out_size, ws_size, (size_t)WS_END); grid = -1; return; }
        int dev = 0, cus = 0, per_cu = 0;
        (void)hipGetDevice(&dev);
        (void)hipDeviceGetAttribute(&cus, hipDeviceAttributeMultiprocessorCount, dev);
        (void)hipFuncSetAttribute((const void*)fwd_megakernel, hipFuncAttributeMaxDynamicSharedMemorySize, LDS_BYTES);
        if (hipOccupancyMaxActiveBlocksPerMultiprocessor(&per_cu, (const void*)fwd_megakernel, NWAVES * 64, LDS_BYTES) != hipSuccess || per_cu < 1) per_cu = 1;
        (void)hipGetLastError();
        if (cus <= 0) cus = 256;
        grid = cus * per_cu;
    }
    if (grid < 0) return;
    Args a{};
    for (int i = 0; i < 21; ++i) a.in[i] = (const float*)d_in[i];
    a.out = (float*)d_out; a.ws = (unsigned char*)d_ws;
    void* args[] = {&a};
    hipError_t e = hipLaunchCooperativeKernel((const void*)fwd_megakernel, dim3(grid), dim3(NWAVES * 64), args, LDS_BYTES, stream);
    if (e != hipSuccess) fprintf(stderr, "cooperative launch failed: %s (grid %d)\n", hipGetErrorString(e), grid);
}
```

```cpp
#include <hip/hip_runtime.h>
#include <hip/hip_cooperative_groups.h>
#include <cstdio>
#include <cstdint>
namespace cg = cooperative_groups;

namespace pg8 {
#define PG8_LAS __attribute__((address_space(3)))
typedef unsigned short bf16_t;
typedef short bf16x8 __attribute__((ext_vector_type(8)));
typedef float f32x4 __attribute__((ext_vector_type(4)));
typedef unsigned u32x4 __attribute__((ext_vector_type(4)));
constexpr int BM = 256, BK = 64, HALF = 128, HTB = HALF * BK * 2  , STAGE_BYTES = 8 * HTB, NXCD = 8, WGM = 8;

__host__ __device__ __forceinline__ int lds_byte(int r, int c) { const int st = (r >> 4) * 2 + (c >> 5), rr = r & 15, cc = c & 31, ob = rr * 64 + cc * 2; return st * 1024 + (ob ^ (((ob >> 9) & 1) << 5)); }
__host__ __device__ __forceinline__ void stage_rc(int b, int& R, int& C) { const int st = b / 1024, sb = b % 1024, swz = sb ^ (((sb >> 9) & 1) << 5); R = (st >> 1) * 16 + swz / 64; C = (st & 1) * 32 + (swz % 64) / 2; }
__host__ __device__ __forceinline__ int perm32(int rho) { const int n = rho >> 4, i = rho & 15; return 8 * (i >> 2) + 4 * n + (i & 3); }

struct Unit { int pm, pn; };
struct Gemm { const bf16_t* A; const bf16_t* Bt; int M, N, K, lda, ldb; };

struct StaticOrder {
    int nM, nN, nwg, G, c;
    __host__ __device__ void init(int M, int N, int G_, int c_) { nM = M / BM; nN = N / BM; nwg = nM * nN; G = G_; c = c_; }
    __host__ __device__ bool next(int i, Unit& u) const {
        const long L = (long)i * G + c; if (L >= nwg) return false;
        int wgid = (int)L; { const int q = nwg / NXCD, r = nwg % NXCD, xcd = wgid % NXCD, off = wgid / NXCD; wgid = (xcd < r ? xcd * (q + 1) : r * (q + 1) + (xcd - r) * q) + off; }
        const int nig = WGM * nN, gid = wgid / nig, fm = gid * WGM, gsz = (nM - fm) < WGM ? (nM - fm) : WGM;
        u.pm = fm + ((wgid % nig) % gsz); u.pn = (wgid % nig) / gsz; return true;
    }
    __device__ __forceinline__ void a_ready(const Unit&) const {}
    __device__ __forceinline__ void done(const Unit&) const {}
};

typedef __bf16 bf16x2_t __attribute__((ext_vector_type(2)));
typedef float f32x2_t __attribute__((ext_vector_type(2)));
__device__ __forceinline__ unsigned pk_bf16(float lo, float hi) { f32x2_t v = {lo, hi}; bf16x2_t b = __builtin_convertvector(v, bf16x2_t); return __builtin_bit_cast(unsigned, b); }
__device__ __forceinline__ float bf_lo(unsigned w) { return __uint_as_float(w << 16); }
__device__ __forceinline__ float bf_hi(unsigned w) { return __uint_as_float(w & 0xffff0000u); }
__device__ __forceinline__ u32x4 pack8(const f32x4 a, const f32x4 b) { u32x4 w; w.x = pk_bf16(a[0], a[1]); w.y = pk_bf16(a[2], a[3]); w.z = pk_bf16(b[0], b[1]); w.w = pk_bf16(b[2], b[3]); return w; }
#define PG8_ROWFENCE() asm volatile("" ::: "memory")

struct EpiQKV {
    static constexpr bool PERM = true, AFTER_DRAIN = false;
    bf16_t *PA, *PB, *PC, *PD, *PE, *PF; float qscale; unsigned* stats;
    __device__ __forceinline__ void operator()(const f32x4 (&acc)[2][2][4][2], const Unit& u, int wr, int wc, int fr, int fq) const {
        const int pn = u.pn; bf16_t* base; int ld = 1024, cb; float sc = 1.f;
        if (pn < 8) {
            const float s0 = pn < 4 ? qscale : 1.f; float rmax[2] = {0.f, 0.f};
#pragma unroll
            for (int ai = 0; ai < 2; ++ai)
#pragma unroll
                for (int m = 0; m < 4; ++m)
#pragma unroll
                    for (int bj = 0; bj < 2; ++bj) { const f32x4 a = acc[ai][bj][m][0] * s0, b = acc[ai][bj][m][1] * s0;
                        float q = (a[0] * a[0] + a[1] * a[1]) + (a[2] * a[2] + a[3] * a[3]) + (b[0] * b[0] + b[1] * b[1]) + (b[2] * b[2] + b[3] * b[3]);
                        q += __shfl_xor(q, 16); q += __shfl_xor(q, 32); rmax[bj] = fmaxf(rmax[bj], q); }
#pragma unroll
            for (int bj = 0; bj < 2; ++bj) { float q = rmax[bj];
                q = fmaxf(q, __shfl_xor(q, 1)); q = fmaxf(q, __shfl_xor(q, 2)); q = fmaxf(q, __shfl_xor(q, 4)); q = fmaxf(q, __shfl_xor(q, 8));
                const int rowt = u.pm * BM, seq = rowt < 65536 ? (rowt >> 13) : 8 + ((rowt - 65536) >> 14);
                if (fr == 0 && fq == 0) atomicMax(stats + (seq * 2 + (pn >> 2)) * 32 + (pn & 3) * 8 + bj * 4 + wc, __float_as_uint(q)); }
        }
        if (pn < 4) { base = PA; cb = pn * 256; sc = qscale; }
        else if (pn < 8) { base = PB; cb = (pn - 4) * 256; }
        else if (pn < 12) { base = PC; cb = (pn - 8) * 256; }
        else if (pn < 16) { base = PD; cb = (pn - 12) * 256; sc = qscale; }
        else if (pn == 16) { base = PE; ld = 256; cb = 0; }
        else { base = PF; ld = 256; cb = 0; }
        const int row0 = u.pm * BM + wr * 64 + fr, col0 = cb + wc * 32 + 8 * fq;
#pragma unroll
        for (int ai = 0; ai < 2; ++ai)
#pragma unroll
            for (int m = 0; m < 4; ++m) { bf16_t* rowp = base + (size_t)(row0 + ai * HALF + m * 16) * ld + col0;
#pragma unroll
                for (int bj = 0; bj < 2; ++bj) *(u32x4*)(rowp + bj * HALF) = pack8(acc[ai][bj][m][0] * sc, acc[ai][bj][m][1] * sc); }
    }
};
struct EpiGate {
    static constexpr bool PERM = true, AFTER_DRAIN = false;
    bf16_t* G; const float* bias;
    __device__ __forceinline__ void operator()(const f32x4 (&acc)[2][2][4][2], const Unit& u, int wr, int wc, int fr, int fq) const {
        const int row0 = u.pm * BM + wr * 64 + fr, col0 = u.pn * BM + wc * 32 + 8 * fq;
        f32x4 bv[2][2];
#pragma unroll
        for (int bj = 0; bj < 2; ++bj)
#pragma unroll
            for (int n = 0; n < 2; ++n) bv[bj][n] = *(const f32x4*)(bias + col0 + bj * HALF + 4 * n);
#pragma unroll
        for (int ai = 0; ai < 2; ++ai)
#pragma unroll
            for (int m = 0; m < 4; ++m) { bf16_t* rowp = G + (size_t)(row0 + ai * HALF + m * 16) * 2048 + col0;
#pragma unroll
                for (int bj = 0; bj < 2; ++bj) { f32x4 v0 = acc[ai][bj][m][0] + bv[bj][0], v1 = acc[ai][bj][m][1] + bv[bj][1];
#pragma unroll
                    for (int e = 0; e < 4; ++e) { v0[e] = __builtin_amdgcn_rcpf(1.f + __expf(-v0[e])); v1[e] = __builtin_amdgcn_rcpf(1.f + __expf(-v1[e])); }
                    *(u32x4*)(rowp + bj * HALF) = pack8(v0, v1); } }
    }
};
template <bool SECOND> struct EpiBranch {
    static constexpr bool PERM = true, AFTER_DRAIN = false;
    bf16_t* G;
    __device__ __forceinline__ void operator()(const f32x4 (&acc)[2][2][4][2], const Unit& u, int wr, int wc, int fr, int fq) const {
        const int row0 = u.pm * BM + wr * 64 + fr, col0 = u.pn * BM + wc * 32 + 8 * fq;
#pragma unroll
        for (int ai = 0; ai < 2; ++ai)
#pragma unroll
            for (int m = 0; m < 4; ++m) { bf16_t* rowp = G + (size_t)(row0 + ai * HALF + m * 16) * 2048 + col0;
#pragma unroll
                for (int bj = 0; bj < 2; ++bj) {
                    const u32x4 gw = *(const u32x4*)(rowp + bj * HALF + (SECOND ? 1024 : 0));
                    const f32x4 a0 = acc[ai][bj][m][0], a1 = acc[ai][bj][m][1];
                    f32x4 v0 = {bf_lo(gw.x) * a0[0], bf_hi(gw.x) * a0[1], bf_lo(gw.y) * a0[2], bf_hi(gw.y) * a0[3]};
                    f32x4 v1 = {bf_lo(gw.z) * a1[0], bf_hi(gw.z) * a1[1], bf_lo(gw.w) * a1[2], bf_hi(gw.w) * a1[3]};
                    if (SECOND) { const u32x4 pw = *(const u32x4*)(rowp + bj * HALF);
                        v0 += (f32x4){bf_lo(pw.x), bf_hi(pw.x), bf_lo(pw.y), bf_hi(pw.y)}; v1 += (f32x4){bf_lo(pw.z), bf_hi(pw.z), bf_lo(pw.w), bf_hi(pw.w)}; }
                    *(u32x4*)(rowp + bj * HALF) = pack8(v0, v1); }
                PG8_ROWFENCE(); }
    }
};
struct EpiFF1 {
    static constexpr bool PERM = true, AFTER_DRAIN = false;
    bf16_t* H; const float* bias;
    __device__ __forceinline__ void operator()(const f32x4 (&acc)[2][2][4][2], const Unit& u, int wr, int wc, int fr, int fq) const {
        const int row0 = u.pm * BM + wr * 64 + fr, col0 = u.pn * BM + wc * 32 + 8 * fq;
        f32x4 bv[2][2];
#pragma unroll
        for (int bj = 0; bj < 2; ++bj)
#pragma unroll
            for (int n = 0; n < 2; ++n) bv[bj][n] = *(const f32x4*)(bias + col0 + bj * HALF + 4 * n);
#pragma unroll
        for (int ai = 0; ai < 2; ++ai)
#pragma unroll
            for (int m = 0; m < 4; ++m) { bf16_t* rowp = H + (size_t)(row0 + ai * HALF + m * 16) * 4096 + col0;
#pragma unroll
                for (int bj = 0; bj < 2; ++bj) { f32x4 v0 = acc[ai][bj][m][0] + bv[bj][0], v1 = acc[ai][bj][m][1] + bv[bj][1];
#pragma unroll
                    for (int e = 0; e < 4; ++e) { v0[e] = fmaxf(v0[e], 0.f); v1[e] = fmaxf(v1[e], 0.f); }
                    *(u32x4*)(rowp + bj * HALF) = pack8(v0 * v0, v1 * v1); } }
    }
};
struct EpiRes {
    static constexpr bool PERM = false, AFTER_DRAIN = false;
    const float* resA; const float* resB; int splitRow; float* out; const float* bias; float alpha;
    __device__ __forceinline__ void operator()(const f32x4 (&acc)[2][2][4][2], const Unit& u, int wr, int wc, int fr, int fq) const {
        const int rowt = u.pm * BM; const int col0 = u.pn * BM + wc * 32 + 4 * fq;
        const float* rbase = rowt < splitRow ? resA + (size_t)rowt * 1024 : resB + (size_t)(rowt - splitRow) * 1024;
        float* obase = out + (size_t)rowt * 1024;
        f32x4 bv[2][2];
#pragma unroll
        for (int bj = 0; bj < 2; ++bj)
#pragma unroll
            for (int n = 0; n < 2; ++n) bv[bj][n] = bias ? *(const f32x4*)(bias + col0 + bj * HALF + n * 16) : (f32x4){0.f, 0.f, 0.f, 0.f};
#pragma unroll
        for (int ai = 0; ai < 2; ++ai)
#pragma unroll
            for (int m = 0; m < 4; ++m) { const size_t off = (size_t)(wr * 64 + fr + ai * HALF + m * 16) * 1024 + col0;
#pragma unroll
                for (int bj = 0; bj < 2; ++bj)
#pragma unroll
                    for (int n = 0; n < 2; ++n) { const f32x4 x = *(const f32x4*)(rbase + off + bj * HALF + n * 16);
                        *(f32x4*)(obase + off + bj * HALF + n * 16) = x * alpha + acc[ai][bj][m][n] + bv[bj][n]; }
                PG8_ROWFENCE(); }
    }
};

template <class Epi, class Sched, bool ALIGN_EPI = false, bool SP2 = false>
__device__ __forceinline__ void gemm_phase(PG8_LAS unsigned char* lds, const Gemm g, const Sched& S, const Epi& E) {
    int tid_ = threadIdx.x; asm volatile("" : "+v"(tid_));
    const int tid = tid_, wid = __builtin_amdgcn_readfirstlane(tid >> 6), lane = tid & 63, wr = wid >> 2, wc = wid & 3, fr = lane & 15, fq = lane >> 4;
    const int K = g.K, nt = K / BK;
    unsigned voffA[2], voffB[2];
#pragma unroll
    for (int i = 0; i < 2; ++i) { int R, C; stage_rc(tid * 16 + i * 8192, R, C); const int Rb = Epi::PERM ? ((R & ~31) + perm32(R & 31)) : R;
        voffA[i] = (unsigned)(R * g.lda + C) * 2u; voffB[i] = (unsigned)(Rb * g.ldb + C) * 2u; }
    const size_t kstep = (size_t)(BK * 2);
    const size_t hstepA = (size_t)HALF * g.lda * 2, hstepB = (size_t)HALF * g.ldb * 2;
    const size_t tstepA = 2 * hstepA, tstepB = 2 * hstepB;
    const unsigned ldsw = (unsigned)wid * 1024u;
    const int aoff = lds_byte(wr * 64 + fr, fq * 8), boff = lds_byte(wc * 32 + fr, fq * 8);
#define PG8_SA(b, h) (((b) * 2 + (h)) * HTB)
#define PG8_SB(b, h) ((4 + (b) * 2 + (h)) * HTB)
#define PG8_STAGE(bufoff, gbase, voff) do { _Pragma("unroll") for (int _i = 0; _i < 2; ++_i) \
        __builtin_amdgcn_global_load_lds((const unsigned*)((const char*)(gbase) + (voff)[_i]), (PG8_LAS unsigned*)(lds + (bufoff) + ldsw + _i * 8192), 16, 0, 0); } while (0)
#define PG8_LDA(dst, b, h) do { _Pragma("unroll") for (int m = 0; m < 4; ++m) _Pragma("unroll") for (int k = 0; k < 2; ++k) dst[m][k] = *(const PG8_LAS bf16x8*)(lds + PG8_SA(b, h) + aoff + m * 2048 + k * 1024); } while (0)
#define PG8_LDB(dst, b, h) do { _Pragma("unroll") for (int n = 0; n < 2; ++n) _Pragma("unroll") for (int k = 0; k < 2; ++k) dst[n][k] = *(const PG8_LAS bf16x8*)(lds + PG8_SB(b, h) + boff + n * 2048 + k * 1024); } while (0)
#define PG8_MMA(ai, bj, At, Bt) do { __builtin_amdgcn_s_setprio(1); _Pragma("unroll") for (int m = 0; m < 4; ++m) _Pragma("unroll") for (int n = 0; n < 2; ++n) _Pragma("unroll") for (int k = 0; k < 2; ++k) \
        acc[ai][bj][m][n] = __builtin_amdgcn_mfma_f32_16x16x32_bf16(Bt[n][k], At[m][k], acc[ai][bj][m][n], 0, 0, 0); __builtin_amdgcn_s_setprio(0); } while (0)
#define PG8_WAIT_V(n) asm volatile("s_waitcnt vmcnt(" #n ")" ::: "memory")
#define PG8_WAIT_L(n) asm volatile("s_waitcnt lgkmcnt(" #n ")" ::: "memory")
#define PG8_BAR __builtin_amdgcn_s_barrier()
#define PG8_SCHED __builtin_amdgcn_sched_barrier(0)
    Unit cur, nxt; int ui = 0;
    if (!S.next(0, cur)) return;
    f32x4 acc[2][2][4][2];
#pragma unroll
    for (int a = 0; a < 2; ++a)
#pragma unroll
        for (int b = 0; b < 2; ++b)
#pragma unroll
            for (int m = 0; m < 4; ++m)
#pragma unroll
                for (int n = 0; n < 2; ++n) acc[a][b][m][n] = (f32x4){0.f, 0.f, 0.f, 0.f};
    bf16x8 At[4][2], B0[2][2], B1[2][2];
    const char* cA = (const char*)g.A + (size_t)cur.pm * tstepA; const char* cB = (const char*)g.Bt + (size_t)cur.pn * tstepB;
    S.a_ready(cur);
    if constexpr (SP2) {
        PG8_STAGE(PG8_SB(0, 0), cB, voffB); PG8_STAGE(PG8_SB(0, 1), cB + hstepB, voffB); PG8_STAGE(PG8_SA(0, 0), cA, voffA); PG8_STAGE(PG8_SA(0, 1), cA + hstepA, voffA);
        if (wr == 1) PG8_BAR;
        PG8_WAIT_V(2); PG8_BAR;
        PG8_STAGE(PG8_SB(1, 0), cB + kstep, voffB); PG8_STAGE(PG8_SA(1, 0), cA + kstep, voffA); PG8_STAGE(PG8_SB(1, 1), cB + hstepB + kstep, voffB);
        PG8_WAIT_V(6); PG8_BAR;
    } else {
        PG8_STAGE(PG8_SB(0, 0), cB, voffB); PG8_STAGE(PG8_SA(0, 0), cA, voffA); PG8_STAGE(PG8_SB(0, 1), cB + hstepB, voffB); PG8_STAGE(PG8_SA(0, 1), cA + hstepA, voffA);
        if (wr == 1) PG8_BAR;
        PG8_WAIT_V(4); PG8_BAR;
        PG8_STAGE(PG8_SB(1, 0), cB + kstep, voffB); PG8_STAGE(PG8_SA(1, 0), cA + kstep, voffA); PG8_STAGE(PG8_SB(1, 1), cB + hstepB + kstep, voffB);
        PG8_WAIT_V(6); PG8_BAR;
    }
    for (;;) {
        const bool has_next = S.next(ui + 1, nxt);
        const char* nA = has_next ? (const char*)g.A + (size_t)nxt.pm * tstepA : cA; const char* nB = has_next ? (const char*)g.Bt + (size_t)nxt.pn * tstepB : cB;
        for (int t = 0; t < nt; t += 2) {
            const bool last = (t == nt - 2);
            const char* a1 = cA + (size_t)(t + 1) * kstep;
            const char* a2 = last ? nA : cA + (size_t)(t + 2) * kstep; const char* b2 = last ? nB : cB + (size_t)(t + 2) * kstep;
            const char* a3 = a2 + kstep; const char* b3 = b2 + kstep;
            if (last && has_next) S.a_ready(nxt);
            if constexpr (SP2) {
            PG8_LDB(B0, 0, 0); PG8_LDB(B1, 0, 1); PG8_SCHED; PG8_LDA(At, 0, 0); PG8_STAGE(PG8_SA(1, 1), a1 + hstepA, voffA);
            PG8_WAIT_V(8); PG8_WAIT_L(0); PG8_BAR; PG8_MMA(0, 0, At, B0); PG8_MMA(0, 1, At, B1); PG8_BAR; PG8_SCHED;
            PG8_LDA(At, 0, 1); PG8_STAGE(PG8_SB(0, 0), b2, voffB); PG8_STAGE(PG8_SB(0, 1), b2 + hstepB, voffB); PG8_STAGE(PG8_SA(0, 0), a2, voffA);
            PG8_WAIT_V(8); PG8_WAIT_L(0); PG8_BAR; PG8_MMA(1, 0, At, B0); PG8_MMA(1, 1, At, B1); PG8_BAR; PG8_SCHED;
            PG8_LDB(B0, 1, 0); PG8_LDB(B1, 1, 1); PG8_SCHED; PG8_LDA(At, 1, 0); PG8_STAGE(PG8_SA(0, 1), a2 + hstepA, voffA);
            PG8_WAIT_V(8); PG8_WAIT_L(0); PG8_BAR; PG8_MMA(0, 0, At, B0); PG8_MMA(0, 1, At, B1); PG8_BAR; PG8_SCHED;
            PG8_LDA(At, 1, 1); PG8_STAGE(PG8_SB(1, 0), b3, voffB); PG8_STAGE(PG8_SB(1, 1), b3 + hstepB, voffB); PG8_STAGE(PG8_SA(1, 0), a3, voffA);
            PG8_WAIT_V(8); PG8_WAIT_L(0); PG8_BAR; PG8_MMA(1, 0, At, B0); PG8_MMA(1, 1, At, B1); PG8_BAR; PG8_SCHED;
            } else {
            PG8_LDB(B0, 0, 0); PG8_SCHED; PG8_LDA(At, 0, 0); PG8_STAGE(PG8_SA(1, 1), a1 + hstepA, voffA);
            PG8_WAIT_L(8); PG8_BAR; PG8_WAIT_L(0); PG8_MMA(0, 0, At, B0); PG8_BAR; PG8_SCHED;
            PG8_LDB(B1, 0, 1); PG8_STAGE(PG8_SB(0, 0), b2, voffB);
            PG8_BAR; PG8_WAIT_L(0); PG8_MMA(0, 1, At, B1); PG8_BAR;
            PG8_LDA(At, 0, 1); PG8_STAGE(PG8_SA(0, 0), a2, voffA);
            PG8_BAR; PG8_WAIT_L(0); PG8_MMA(1, 0, At, B0); PG8_BAR; PG8_SCHED;
            PG8_STAGE(PG8_SB(0, 1), b2 + hstepB, voffB);
            PG8_WAIT_V(6); PG8_BAR; PG8_MMA(1, 1, At, B1); PG8_BAR;
            PG8_LDB(B0, 1, 0); PG8_SCHED; PG8_LDA(At, 1, 0); PG8_STAGE(PG8_SA(0, 1), a2 + hstepA, voffA);
            PG8_WAIT_L(8); PG8_BAR; PG8_WAIT_L(0); PG8_MMA(0, 0, At, B0); PG8_BAR; PG8_SCHED;
            PG8_LDB(B1, 1, 1); PG8_STAGE(PG8_SB(1, 0), b3, voffB);
            PG8_BAR; PG8_WAIT_L(0); PG8_MMA(0, 1, At, B1); PG8_BAR;
            PG8_LDA(At, 1, 1); PG8_STAGE(PG8_SA(1, 0), a3, voffA);
            PG8_BAR; PG8_WAIT_L(0); PG8_MMA(1, 0, At, B0); PG8_BAR; PG8_SCHED;
            PG8_STAGE(PG8_SB(1, 1), b3 + hstepB, voffB);
            PG8_WAIT_V(6); PG8_BAR; PG8_MMA(1, 1, At, B1); PG8_BAR;
            }
        }
        if constexpr (ALIGN_EPI) { if (wr == 0) PG8_BAR; }
        if constexpr (!Epi::AFTER_DRAIN) { E(acc, cur, wr, wc, fr, fq); S.done(cur); }
        if (!has_next) break;
#pragma unroll
        for (int a = 0; a < 2; ++a)
#pragma unroll
            for (int b = 0; b < 2; ++b)
#pragma unroll
                for (int m = 0; m < 4; ++m)
#pragma unroll
                    for (int n = 0; n < 2; ++n) acc[a][b][m][n] = (f32x4){0.f, 0.f, 0.f, 0.f};
        cur = nxt; cA = nA; cB = nB; ++ui;
        if constexpr (ALIGN_EPI) { if (wr == 1) PG8_BAR; }
    }
    PG8_WAIT_V(0);
    if constexpr (!ALIGN_EPI) { if (wr == 0) PG8_BAR; }
    PG8_BAR;
    if constexpr (Epi::AFTER_DRAIN) { E.fused(acc, cur, wr, wc, fr, fq, lds, wid, lane); S.done(cur); }
#undef PG8_SA
#undef PG8_SB
#undef PG8_STAGE
#undef PG8_LDA
#undef PG8_LDB
#undef PG8_MMA
#undef PG8_WAIT_V
#undef PG8_WAIT_L
#undef PG8_BAR
#undef PG8_SCHED
}
}

namespace att {
#define ATT_LAS __attribute__((address_space(3)))
typedef unsigned short bf16_t;
typedef short bf16x8 __attribute__((ext_vector_type(8)));
typedef short s16x4 __attribute__((ext_vector_type(4)));
typedef float f32x16 __attribute__((ext_vector_type(16)));
typedef unsigned u32x4 __attribute__((ext_vector_type(4)));
typedef unsigned u32x2 __attribute__((ext_vector_type(2)));
typedef ATT_LAS unsigned char* ldsp;
constexpr float LOG2E = 1.4426950408889634f;
constexpr float QSCALE = 0.125f * LOG2E;
constexpr float LN_EPS = 1e-5f;
#define ATT_MFMA(a, b, c) __builtin_amdgcn_mfma_f32_32x32x16_bf16((a), (b), (c), 0, 0, 0)
__device__ __forceinline__ s16x4 vtr(ldsp p) { return __builtin_bit_cast(s16x4, __builtin_amdgcn_ds_read_tr16_b64_v4i16((ATT_LAS s16x4*)p)); }
__device__ __forceinline__ bf16x8 pack_frag(const f32x16& x, int s8) {
    u32x4 p; p.x = pg8::pk_bf16(x[s8], x[s8 + 1]); p.y = pg8::pk_bf16(x[s8 + 2], x[s8 + 3]); p.z = pg8::pk_bf16(x[s8 + 4], x[s8 + 5]); p.w = pg8::pk_bf16(x[s8 + 6], x[s8 + 7]);
    return __builtin_bit_cast(bf16x8, p);
}
__device__ __forceinline__ int voff(int key, int ch  ) { return (ch >> 2) * 4096 + (key >> 4) * 1024 + ((key >> 3) & 1) * 512 + (key & 7) * 64 + (ch & 3) * 16; }

constexpr int DKP = 272;
constexpr int DKBUF = 64 * DKP, DVBUF = 64 * 256, DBUF = DKBUF + DVBUF;
constexpr int DXOFF = 2 * DBUF;
constexpr int D_LDS = DXOFF + 65536;

__device__ __forceinline__ void diff_unit(ldsp lds, const bf16_t* Qp, const bf16_t* Kp, const bf16_t* Vp, bf16_t* Op,
                                          long rowbase, int S, int h, int qblk, float lam, const float* __restrict__ subln_g, const unsigned* stats  ) {
    int tid_ = threadIdx.x; asm volatile("" : "+v"(tid_));
    const int tid = tid_, lane = tid & 63, r = lane & 31, hh = lane >> 5;
    const int wid = __builtin_amdgcn_readfirstlane(tid >> 6), c = wid >> 2, qsub = wid & 3;
    const int q0 = qblk * 128, qpos = q0 + qsub * 32 + r;
    const float nslope2 = -LOG2E * __builtin_amdgcn_exp2f(-(float)(h + 1));
    bf16x8 qf[4];
    { const bf16_t* qptr = Qp + (size_t)(rowbase + qpos) * 1024 + h * 128 + c * 64 + hh * 8;
#pragma unroll
      for (int ks = 0; ks < 4; ++ks) qf[ks] = *(const bf16x8*)(qptr + ks * 16); }
    const int skey = tid >> 4, sch = tid & 15;
    const bf16_t* kg = Kp + (size_t)(rowbase + skey) * 1024 + h * 128 + sch * 8;
    const bf16_t* vg = Vp + (size_t)(rowbase + skey) * 1024 + h * 128 + sch * 8;
    const int NT = S / 64;
    int tlo, thi; bool fast;
    { float b2 = 0.f;
#pragma unroll
      for (int cc = 0; cc < 2; ++cc) { const float qn = __uint_as_float(stats[h * 4 + cc * 2]) + __uint_as_float(stats[h * 4 + cc * 2 + 1]);
          const float kn = __uint_as_float(stats[32 + h * 4 + cc * 2]) + __uint_as_float(stats[32 + h * 4 + cc * 2 + 1]); b2 = fmaxf(b2, qn * kn); }
      const float B = 1.02f * sqrtf(b2); fast = __builtin_amdgcn_readfirstlane((int)(B <= 60.f)) != 0;
      float dcf = (150.f + 2.f * B) / (-nslope2) + 2.f; if (!(dcf < (float)S)) dcf = (float)S;
      const int dc = (int)dcf; const int lo = q0 - dc, hi2 = q0 + 127 + dc;
      tlo = lo <= 0 ? 0 : (lo >> 6); thi = (hi2 >> 6) > NT - 1 ? NT - 1 : (hi2 >> 6);
      tlo = __builtin_amdgcn_readfirstlane(tlo); thi = __builtin_amdgcn_readfirstlane(thi); }
    const int kl0r = skey * DKP + sch * 16, kl1r = (skey + 32) * DKP + sch * 16, vl0r = voff(skey, sch), vl1r = voff(skey + 32, sch);
    float l = 0.f;
    f32x16 o[4];
#pragma unroll
    for (int eb = 0; eb < 4; ++eb)
#pragma unroll
        for (int i = 0; i < 16; ++i) o[eb][i] = 0.f;
    const int kread = r * DKP + c * 128 + hh * 16;
    const int vreadr = (4 * hh + ((lane & 15) >> 2)) * 64 + ((lane >> 4) & 1) * 32 + (lane & 3) * 8;
    u32x4 sk0, sk1, sv0, sv1;
    if (fast) {
        const float slope2 = -nslope2; const int qw0 = q0 + qsub * 32;
#define DF_LOADK(tt) do { const size_t go_ = (size_t)(tt) * 64 * 1024; sk0 = *(const u32x4*)(kg + go_); sk1 = *(const u32x4*)(kg + go_ + 32 * 1024); } while (0)
#define DF_LOADV(tt) do { const size_t go_ = (size_t)(tt) * 64 * 1024; sv0 = *(const u32x4*)(vg + go_); sv1 = *(const u32x4*)(vg + go_ + 32 * 1024); } while (0)
#define DF_STOREK(slot) do { const ldsp b_ = lds + (slot) * DKBUF; *(ATT_LAS u32x4*)(b_ + kl0r) = sk0; *(ATT_LAS u32x4*)(b_ + kl1r) = sk1; } while (0)
#define DF_STOREV(slot) do { const ldsp b_ = lds + 2 * DKBUF + (slot) * DVBUF; *(ATT_LAS u32x4*)(b_ + vl0r) = sv0; *(ATT_LAS u32x4*)(b_ + vl1r) = sv1; } while (0)
#define DF_CF(i) ((float)(((i) & 3) + 8 * ((i) >> 2)))
#define DF_QK(S0, S1, tt, slot) do { const int tb_ = (tt) * 64; const float db_ = (float)(tb_ + 4 * hh - qpos); \
        if (tb_ + 63 < qw0 || tb_ > qw0 + 31) { const float a_ = (tb_ + 63 < qw0) ? slope2 : -slope2, bl_ = a_ * db_;   \
            _Pragma("unroll") for (int i = 0; i < 16; ++i) { S0[i] = __builtin_fmaf(a_, DF_CF(i), bl_); S1[i] = __builtin_fmaf(a_, DF_CF(i) + 32.f, bl_); } } \
        else { _Pragma("unroll") for (int i = 0; i < 16; ++i) { S0[i] = nslope2 * __builtin_fabsf(db_ + DF_CF(i)); S1[i] = nslope2 * __builtin_fabsf(db_ + DF_CF(i) + 32.f); } } \
        const ldsp kb_ = lds + (slot) * DKBUF + kread; \
        _Pragma("unroll") for (int ks = 0; ks < 4; ++ks) { const bf16x8 k0_ = *(const ATT_LAS bf16x8*)(kb_ + ks * 32), k1_ = *(const ATT_LAS bf16x8*)(kb_ + 32 * DKP + ks * 32); \
            S0 = ATT_MFMA(k0_, qf[ks], S0); S1 = ATT_MFMA(k1_, qf[ks], S1); } } while (0)
#define DF_PV(slot, PF) do { const ldsp vb_ = lds + 2 * DKBUF + (slot) * DVBUF + vreadr; \
        _Pragma("unroll") for (int eb = 0; eb < 4; ++eb) _Pragma("unroll") for (int kk = 0; kk < 4; ++kk) { \
            const s16x4 lo_ = vtr(vb_ + eb * 4096 + kk * 1024), hi_ = vtr(vb_ + eb * 4096 + kk * 1024 + 512); \
            o[eb] = ATT_MFMA(__builtin_shufflevector(lo_, hi_, 0, 1, 2, 3, 4, 5, 6, 7), PF[kk], o[eb]); } } while (0)
#define DF_SOFTMAX(S0, S1, PF) do { \
        _Pragma("unroll") for (int i = 0; i < 16; ++i) { S0[i] = __builtin_amdgcn_exp2f(S0[i]); S1[i] = __builtin_amdgcn_exp2f(S1[i]); } \
        _Pragma("unroll") for (int i = 0; i < 8; ++i) { l2 += (f32x2){S0[2 * i], S0[2 * i + 1]}; l2 += (f32x2){S1[2 * i], S1[2 * i + 1]}; } \
        PF[0] = pack_frag(S0, 0); PF[1] = pack_frag(S0, 8); PF[2] = pack_frag(S1, 0); PF[3] = pack_frag(S1, 8); } while (0)
        typedef float f32x2 __attribute__((ext_vector_type(2)));
        f32x2 l2 = {0.f, 0.f};
        const int n = thi - tlo + 1;
        DF_LOADK(tlo); DF_STOREK(0);
        DF_LOADK(n > 1 ? tlo + 1 : tlo); DF_STOREK(1);
        __syncthreads();
        f32x16 sa0, sa1, sb0, sb1; bf16x8 pf[4];
        DF_QK(sa0, sa1, tlo, 0);
        __syncthreads();
        {
            DF_LOADK(tlo + 2 < thi ? tlo + 2 : thi); DF_LOADV(tlo);
            DF_QK(sb0, sb1, (tlo + 1 < thi ? tlo + 1 : thi), 1);
            DF_SOFTMAX(sa0, sa1, pf);
            DF_STOREK(0); DF_STOREV(0);
            __syncthreads();
            sa0 = sb0; sa1 = sb1;
        }
        for (int j = 1; j < n; ++j) {
            const int T = tlo + j;
            DF_LOADK(T + 2 < thi ? T + 2 : thi); DF_LOADV(T);
            DF_QK(sb0, sb1, (T + 1 < thi ? T + 1 : thi), (j + 1) & 1);
            DF_PV((j - 1) & 1, pf);
            DF_SOFTMAX(sa0, sa1, pf);
            DF_STOREK(j & 1); DF_STOREV(j & 1);
            __syncthreads();
            sa0 = sb0; sa1 = sb1;
        }
        DF_PV((n - 1) & 1, pf);
        l = l2.x + l2.y;
#undef DF_LOADK
#undef DF_LOADV
#undef DF_STOREK
#undef DF_STOREV
#undef DF_CF
#undef DF_QK
#undef DF_PV
#undef DF_SOFTMAX
    } else {
    const int kl0 = kl0r, kl1 = kl1r, vl0 = DKBUF + vl0r, vl1 = DKBUF + vl1r, vread = DKBUF + vreadr;
    float m = -1e30f;
    { const size_t go = (size_t)tlo * 64 * 1024;
      sk0 = *(const u32x4*)(kg + go); sk1 = *(const u32x4*)(kg + go + 32 * 1024); sv0 = *(const u32x4*)(vg + go); sv1 = *(const u32x4*)(vg + go + 32 * 1024); }
    *(ATT_LAS u32x4*)(lds + kl0) = sk0; *(ATT_LAS u32x4*)(lds + kl1) = sk1; *(ATT_LAS u32x4*)(lds + vl0) = sv0; *(ATT_LAS u32x4*)(lds + vl1) = sv1;
    __syncthreads();
    for (int t = tlo; t <= thi; ++t) {
        const int bsel = (t - tlo) & 1;
        const ldsp cur = lds + bsel * DBUF;
        const bool more = (t < thi);
        if (more) { const size_t go = (size_t)(t + 1) * 64 * 1024;
            sk0 = *(const u32x4*)(kg + go); sk1 = *(const u32x4*)(kg + go + 32 * 1024); sv0 = *(const u32x4*)(vg + go); sv1 = *(const u32x4*)(vg + go + 32 * 1024); }
        f32x16 s0, s1;
#pragma unroll
        for (int i = 0; i < 16; ++i) { s0[i] = 0.f; s1[i] = 0.f; }
#pragma unroll
        for (int ks = 0; ks < 4; ++ks) {
            const bf16x8 k0 = *(const ATT_LAS bf16x8*)(cur + kread + ks * 32);
            const bf16x8 k1 = *(const ATT_LAS bf16x8*)(cur + kread + 32 * DKP + ks * 32);
            s0 = ATT_MFMA(k0, qf[ks], s0); s1 = ATT_MFMA(k1, qf[ks], s1);
        }
        const float dbase = (float)(t * 64 + 4 * hh - qpos);
        float mx = -1e30f;
#pragma unroll
        for (int i = 0; i < 16; ++i) { const float d0 = dbase + (float)((i & 3) + 8 * (i >> 2));
            s0[i] = __builtin_fmaf(nslope2, __builtin_fabsf(d0), s0[i]); s1[i] = __builtin_fmaf(nslope2, __builtin_fabsf(d0 + 32.f), s1[i]);
            mx = fmaxf(mx, fmaxf(s0[i], s1[i])); }
        mx = fmaxf(mx, __shfl_xor(mx, 32));
        if (__any(mx > m)) { const float mn = fmaxf(m, mx), al = __builtin_amdgcn_exp2f(m - mn); m = mn; l *= al;
#pragma unroll
            for (int eb = 0; eb < 4; ++eb) o[eb] *= al; }
        float rs = 0.f;
#pragma unroll
        for (int i = 0; i < 16; ++i) { s0[i] = __builtin_amdgcn_exp2f(s0[i] - m); s1[i] = __builtin_amdgcn_exp2f(s1[i] - m); rs += s0[i] + s1[i]; }
        l += rs;
        bf16x8 pf[4]; pf[0] = pack_frag(s0, 0); pf[1] = pack_frag(s0, 8); pf[2] = pack_frag(s1, 0); pf[3] = pack_frag(s1, 8);
#pragma unroll
        for (int eb = 0; eb < 4; ++eb)
#pragma unroll
            for (int kk = 0; kk < 4; ++kk) {
                const s16x4 lo = vtr(cur + vread + eb * 4096 + kk * 1024), hi = vtr(cur + vread + eb * 4096 + kk * 1024 + 512);
                const bf16x8 vf = __builtin_shufflevector(lo, hi, 0, 1, 2, 3, 4, 5, 6, 7);
                o[eb] = ATT_MFMA(vf, pf[kk], o[eb]);
            }
        if (more) { const ldsp nx = lds + (bsel ^ 1) * DBUF;
            *(ATT_LAS u32x4*)(nx + kl0) = sk0; *(ATT_LAS u32x4*)(nx + kl1) = sk1; *(ATT_LAS u32x4*)(nx + vl0) = sv0; *(ATT_LAS u32x4*)(nx + vl1) = sv1; }
        __syncthreads();
    }
    }
    l += __shfl_xor(l, 32);
    const float inv = 1.f / l;
    ATT_LAS float* X = (ATT_LAS float*)(lds + DXOFF) + qsub * 4096 + lane;
    if (c == 1) {
#pragma unroll
        for (int eb = 0; eb < 4; ++eb)
#pragma unroll
            for (int i = 0; i < 16; ++i) X[(eb * 16 + i) * 64] = o[eb][i] * inv;
    }
    __syncthreads();
    if (c == 0) {
        float ss = 0.f;
#pragma unroll
        for (int eb = 0; eb < 4; ++eb)
#pragma unroll
            for (int i = 0; i < 16; ++i) { const float v = o[eb][i] * inv - lam * X[(eb * 16 + i) * 64]; o[eb][i] = v; ss += v * v; }
        ss += __shfl_xor(ss, 32);
        const float rn = 0.8f * __builtin_amdgcn_rsqf(ss * (1.f / 128.f) + LN_EPS);
        bf16_t* orow = Op + (size_t)(rowbase + qpos) * 1024 + h * 128 + 4 * hh;
#pragma unroll
        for (int eb = 0; eb < 4; ++eb)
#pragma unroll
            for (int g4 = 0; g4 < 4; ++g4) { const int e0 = eb * 32 + 8 * g4;
                const float4 gv = *(const float4*)(subln_g + e0 + 4 * hh);
                u32x2 w; w.x = pg8::pk_bf16(o[eb][4 * g4] * rn * gv.x, o[eb][4 * g4 + 1] * rn * gv.y); w.y = pg8::pk_bf16(o[eb][4 * g4 + 2] * rn * gv.z, o[eb][4 * g4 + 3] * rn * gv.w);
                *(u32x2*)(orow + e0) = w; }
    }
}

constexpr int WKP = 144;
constexpr int WKBUF = 64 * WKP, WVBUF = 64 * 128, WBUF = WKBUF + WVBUF;

__device__ __forceinline__ void win_unit(ldsp lds, const bf16_t* Qp, const bf16_t* Kp, const bf16_t* Vp, bf16_t* Op,
                                         long rowbase, int S, int hq, int qblk, const float* __restrict__ sink) {
    int tid_ = threadIdx.x; asm volatile("" : "+v"(tid_));
    const int tid = tid_, lane = tid & 63, r = lane & 31, hh = lane >> 5;
    const int wid = __builtin_amdgcn_readfirstlane(tid >> 6), g = hq >> 2;
    const int q0 = qblk * 256, qw0 = q0 + wid * 32, qpos = qw0 + r;
    const float nslope2 = -LOG2E * __builtin_amdgcn_exp2f(-0.5f * (float)(hq + 1));
    bf16x8 qf[4];
    { const bf16_t* qptr = Qp + (size_t)(rowbase + qpos) * 1024 + hq * 64 + hh * 8;
#pragma unroll
      for (int ks = 0; ks < 4; ++ks) qf[ks] = *(const bf16x8*)(qptr + ks * 16); }
    const int skey = tid >> 3, sch = tid & 7;
    const bf16_t* kg = Kp + (size_t)(rowbase + skey) * 256 + g * 64 + sch * 8;
    const bf16_t* vg = Vp + (size_t)(rowbase + skey) * 256 + g * 64 + sch * 8;
    const int kl = skey * WKP + sch * 16, vl = WKBUF + voff(skey, sch);
    const int NT = S / 64;
    int tlo = q0 / 64 - 2; if (tlo < 0) tlo = 0;
    int thi = q0 / 64 + 5; if (thi > NT - 1) thi = NT - 1;
    u32x4 sk, sv;
    sk = *(const u32x4*)(kg + (size_t)tlo * 64 * 256); sv = *(const u32x4*)(vg + (size_t)tlo * 64 * 256);
    *(ATT_LAS u32x4*)(lds + kl) = sk; *(ATT_LAS u32x4*)(lds + vl) = sv;
    __syncthreads();
    float m = -1e30f, l = 0.f;
    f32x16 o[2];
#pragma unroll
    for (int eb = 0; eb < 2; ++eb)
#pragma unroll
        for (int i = 0; i < 16; ++i) o[eb][i] = 0.f;
    const int kread = r * WKP + hh * 16;
    const int vread = WKBUF + (4 * hh + ((lane & 15) >> 2)) * 64 + ((lane >> 4) & 1) * 32 + (lane & 3) * 8;
    for (int t = tlo; t <= thi; ++t) {
        const int b = (t - tlo) & 1;
        const ldsp cur = lds + b * WBUF;
        const bool more = (t < thi);
        if (more) { const size_t go = (size_t)(t + 1) * 64 * 256; sk = *(const u32x4*)(kg + go); sv = *(const u32x4*)(vg + go); }
        const bool active = (t * 64 + 63 >= qw0 - 128) && (t * 64 <= qw0 + 31 + 128);
        if (active) {
            f32x16 s0, s1;
#pragma unroll
            for (int i = 0; i < 16; ++i) { s0[i] = 0.f; s1[i] = 0.f; }
#pragma unroll
            for (int ks = 0; ks < 4; ++ks) {
                const bf16x8 k0 = *(const ATT_LAS bf16x8*)(cur + kread + ks * 32);
                const bf16x8 k1 = *(const ATT_LAS bf16x8*)(cur + kread + 32 * WKP + ks * 32);
                s0 = ATT_MFMA(k0, qf[ks], s0); s1 = ATT_MFMA(k1, qf[ks], s1);
            }
            const float dbase = (float)(t * 64 + 4 * hh - qpos);
            float mx = -INFINITY;
#pragma unroll
            for (int i = 0; i < 16; ++i) { const float d0 = __builtin_fabsf(dbase + (float)((i & 3) + 8 * (i >> 2))), d1 = __builtin_fabsf(dbase + (float)(32 + (i & 3) + 8 * (i >> 2)));
                s0[i] = d0 <= 128.f ? __builtin_fmaf(nslope2, d0, s0[i]) : -INFINITY; s1[i] = d1 <= 128.f ? __builtin_fmaf(nslope2, d1, s1[i]) : -INFINITY;
                mx = fmaxf(mx, fmaxf(s0[i], s1[i])); }
            mx = fmaxf(mx, __shfl_xor(mx, 32));
            if (__any(mx > m)) { const float mn = fmaxf(m, mx), al = __builtin_amdgcn_exp2f(m - mn); m = mn; l *= al;
#pragma unroll
                for (int eb = 0; eb < 2; ++eb) o[eb] *= al; }
            float rs = 0.f;
#pragma unroll
            for (int i = 0; i < 16; ++i) { s0[i] = __builtin_amdgcn_exp2f(s0[i] - m); s1[i] = __builtin_amdgcn_exp2f(s1[i] - m); rs += s0[i] + s1[i]; }
            l += rs;
            bf16x8 pf[4]; pf[0] = pack_frag(s0, 0); pf[1] = pack_frag(s0, 8); pf[2] = pack_frag(s1, 0); pf[3] = pack_frag(s1, 8);
#pragma unroll
            for (int eb = 0; eb < 2; ++eb)
#pragma unroll
                for (int kk = 0; kk < 4; ++kk) {
                    const s16x4 lo = vtr(cur + vread + eb * 4096 + kk * 1024), hi = vtr(cur + vread + eb * 4096 + kk * 1024 + 512);
                    const bf16x8 vf = __builtin_shufflevector(lo, hi, 0, 1, 2, 3, 4, 5, 6, 7);
                    o[eb] = ATT_MFMA(vf, pf[kk], o[eb]);
                }
        }
        if (more) { const ldsp nx = lds + (b ^ 1) * WBUF; *(ATT_LAS u32x4*)(nx + kl) = sk; *(ATT_LAS u32x4*)(nx + vl) = sv; }
        __syncthreads();
    }
    l += __shfl_xor(l, 32);
    const float sk2 = sink[hq] * LOG2E, mf = fmaxf(m, sk2), sc = __builtin_amdgcn_exp2f(m - mf);
    const float inv = sc / (l * sc + __builtin_amdgcn_exp2f(sk2 - mf));
    bf16_t* orow = Op + (size_t)(rowbase + qpos) * 1024 + hq * 64 + 4 * hh;
#pragma unroll
    for (int eb = 0; eb < 2; ++eb)
#pragma unroll
        for (int g4 = 0; g4 < 4; ++g4) { const int e0 = eb * 32 + 8 * g4;
            u32x2 w; w.x = pg8::pk_bf16(o[eb][4 * g4] * inv, o[eb][4 * g4 + 1] * inv); w.y = pg8::pk_bf16(o[eb][4 * g4 + 2] * inv, o[eb][4 * g4 + 3] * inv);
            *(u32x2*)(orow + e0) = w; }
}
}

#define LAS __attribute__((address_space(3)))
typedef unsigned short bf16;
typedef unsigned v4u __attribute__((ext_vector_type(4)));
typedef float f32x4 __attribute__((ext_vector_type(4)));
constexpr int NWAVES = 8;
constexpr int T_P = 8 * 8192, T_S = 2 * 16384, T_ALL = T_P + T_S;
constexpr int DM = 1024, DFF = 4096, IN_COLS = 6656, QKV_COLS = 4608, GATE_COLS = 2048;
constexpr float DN_ALPHA = 1.189207115002721f;
constexpr float LN_EPS = 1e-5f;
constexpr int LDS_BYTES = 147456;
static_assert(att::D_LDS <= LDS_BYTES && pg8::STAGE_BYTES <= LDS_BYTES, "LDS map");
constexpr size_t WS_WIN = 0;
constexpr size_t WS_WBRA = WS_WIN + (size_t)IN_COLS * DM * 2;
constexpr size_t WS_WBRB = WS_WBRA + (size_t)DM * DM * 2;
constexpr size_t WS_WOUT = WS_WBRB + (size_t)DM * DM * 2;
constexpr size_t WS_WFF1 = WS_WOUT + (size_t)DM * DM * 2;
constexpr size_t WS_WFF2 = WS_WFF1 + (size_t)DFF * DM * 2;
constexpr size_t WS_BIG = WS_WFF2 + (size_t)DFF * DM * 2;
constexpr size_t PLANE = (size_t)T_ALL * DM * 2;
constexpr size_t WS_PA = WS_BIG, WS_PB = WS_PA + PLANE, WS_PC = WS_PB + PLANE, WS_PD = WS_PC + PLANE;
constexpr size_t WS_TAIL = WS_PD + PLANE;
constexpr size_t WS_PE = WS_TAIL, WS_PF = WS_PE + (size_t)T_ALL * 256 * 2;
constexpr size_t WS_CTL = WS_TAIL + PLANE;
constexpr size_t WS_END = WS_CTL + 8192;
constexpr int LDS_CTL = 135168;
static_assert(att::D_LDS <= LDS_CTL && LDS_CTL + 16 <= 147456, "LDS ctl word");

__device__ __forceinline__ unsigned f2bf(float f) { unsigned u = __builtin_bit_cast(unsigned, f); return (u + 0x7fffu + ((u >> 16) & 1u)) >> 16; }
__device__ __forceinline__ unsigned pk2(float lo, float hi) { return f2bf(lo) | (f2bf(hi) << 16); }
__device__ __forceinline__ float wave_sum(float v) {
#pragma unroll
    for (int o = 1; o < 64; o <<= 1) v += __shfl_xor(v, o);
    return v;
}
__device__ __forceinline__ void p0_transpose_item(const float* W, int K, int N, bf16* WT, LAS float* scr, int item, int lane) {
    const int nblk = N / 32, kb = item / nblk, nb = item % nblk, k0 = 64 * kb, n0 = 32 * nb;
#pragma unroll 8
    for (int i = 0; i < 32; ++i) { const int kk = 2 * i + (lane >> 5); scr[kk * 33 + (lane & 31)] = W[(size_t)(k0 + kk) * N + n0 + (lane & 31)]; }
    asm volatile("s_waitcnt lgkmcnt(0)" ::: "memory");
    const int c = lane & 7;
#pragma unroll
    for (int j = 0; j < 4; ++j) { const int n = (lane >> 3) + 8 * j; const LAS float* s = scr + (8 * c) * 33 + n;
        v4u o; o.x = pk2(s[0 * 33], s[1 * 33]); o.y = pk2(s[2 * 33], s[3 * 33]); o.z = pk2(s[4 * 33], s[5 * 33]); o.w = pk2(s[6 * 33], s[7 * 33]);
        *(v4u*)(WT + (size_t)(n0 + n) * K + k0 + 8 * c) = o; }
    asm volatile("s_waitcnt lgkmcnt(0)" ::: "memory");
}
template <bool WITH_BF16> __device__ __forceinline__ void ln_rows(float* Z, bf16* Zb, const float* __restrict__ gam, const float* __restrict__ bet, int gw, int NGW, int lane) {
    f32x4 gv[4], bv[4];
#pragma unroll
    for (int j = 0; j < 4; ++j) { gv[j] = *((const f32x4*)gam + 64 * j + lane); bv[j] = *((const f32x4*)bet + 64 * j + lane); }
    for (int m = gw; m < T_ALL; m += NGW) {
        f32x4* zr = (f32x4*)(Z + (size_t)m * DM) + lane;
        f32x4 v[4]; float s = 0.f;
#pragma unroll
        for (int j = 0; j < 4; ++j) { v[j] = zr[64 * j]; s += (v[j].x + v[j].y) + (v[j].z + v[j].w); }
        const float mean = wave_sum(s) * (1.f / DM); float s2 = 0.f;
#pragma unroll
        for (int j = 0; j < 4; ++j) { v[j] = v[j] - mean; s2 += (v[j].x * v[j].x + v[j].y * v[j].y) + (v[j].z * v[j].z + v[j].w * v[j].w); }
        const float rstd = 1.f / sqrtf(wave_sum(s2) * (1.f / DM) + LN_EPS);
#pragma unroll
        for (int j = 0; j < 4; ++j) { const f32x4 y = v[j] * rstd * gv[j] + bv[j]; zr[64 * j] = y;
            if (WITH_BF16) { unsigned long long* o8 = (unsigned long long*)(Zb + (size_t)m * DM) + lane;
                o8[64 * j] = (unsigned long long)pk2(y.x, y.y) | ((unsigned long long)pk2(y.z, y.w) << 32); } }
    }
}

struct Args { const float* in[21]; float* out; unsigned char* ws; };

__global__ void __launch_bounds__(NWAVES * 64) fwd_megakernel(Args a) {
    extern __shared__ __attribute__((aligned(16))) unsigned char lds_raw[];
    cg::grid_group grid = cg::this_grid();
    LAS unsigned char* lds = (LAS unsigned char*)lds_raw;
    const int tid = threadIdx.x, lane = tid & 63, wave = __builtin_amdgcn_readfirstlane(tid >> 6);
    const int G = gridDim.x, bx = blockIdx.x;
    const int vcu = (G % 8 == 0) ? (bx % 8) * (G / 8) + bx / 8 : bx;
    const int gw = vcu * NWAVES + wave, NGW = G * NWAVES;
    unsigned char* ws = a.ws;
    bf16* WinT = (bf16*)(ws + WS_WIN); bf16* WbraT = (bf16*)(ws + WS_WBRA); bf16* WbrbT = (bf16*)(ws + WS_WBRB); bf16* WoutT = (bf16*)(ws + WS_WOUT);
    bf16* Wff1T = (bf16*)(ws + WS_WFF1); bf16* Wff2T = (bf16*)(ws + WS_WFF2);
    bf16* PA = (bf16*)(ws + WS_PA); bf16* PB = (bf16*)(ws + WS_PB); bf16* PC = (bf16*)(ws + WS_PC); bf16* PD = (bf16*)(ws + WS_PD);
    bf16* PE = (bf16*)(ws + WS_PE); bf16* PF = (bf16*)(ws + WS_PF);
    bf16* GM = PB;
    bf16* HB = PA;
    bf16* X1B = (bf16*)(ws + WS_TAIL);
    bf16* XB = (bf16*)a.out;
    float* OUT = a.out;

    unsigned* ctl = (unsigned*)(ws + WS_CTL);
    {
        if (bx == 0) for (int i = tid; i < 2048; i += NWAVES * 64) ctl[i] = 0u;
        LAS float* scr = (LAS float*)(lds + wave * 16384);
        constexpr int I_IN = (DM / 64) * (IN_COLS / 32), I_SQ = (DM / 64) * (DM / 32), I_F1 = (DM / 64) * (DFF / 32), I_F2 = (DFF / 64) * (DM / 32);
        constexpr int NITEMS = I_IN + 3 * I_SQ + I_F1 + I_F2;
        for (int it = gw; it < NITEMS; it += NGW) {
            int r = it;
            if (r < I_IN) { p0_transpose_item(a.in[2], DM, IN_COLS, WinT, scr, r, lane); continue; } r -= I_IN;
            if (r < I_SQ) { p0_transpose_item(a.in[10], DM, DM, WbraT, scr, r, lane); continue; } r -= I_SQ;
            if (r < I_SQ) { p0_transpose_item(a.in[11], DM, DM, WbrbT, scr, r, lane); continue; } r -= I_SQ;
            if (r < I_SQ) { p0_transpose_item(a.in[12], DM, DM, WoutT, scr, r, lane); continue; } r -= I_SQ;
            if (r < I_F1) { p0_transpose_item(a.in[15], DM, DFF, Wff1T, scr, r, lane); continue; } r -= I_F1;
            p0_transpose_item(a.in[17], DFF, DM, Wff2T, scr, r, lane);
        }
        const size_t n8 = (size_t)T_ALL * DM / 8, np8 = (size_t)T_P * DM / 8;
        for (size_t i = (size_t)vcu * (NWAVES * 64) + tid; i < n8; i += (size_t)G * (NWAVES * 64)) {
            const float* src = i < np8 ? a.in[0] + i * 8 : a.in[1] + (i - np8) * 8;
            const f32x4 v0 = *(const f32x4*)src, v1 = *(const f32x4*)(src + 4);
            v4u o; o.x = pk2(v0.x, v0.y); o.y = pk2(v0.z, v0.w); o.z = pk2(v1.x, v1.y); o.w = pk2(v1.z, v1.w);
            *(v4u*)(XB + i * 8) = o;
        }
    }
    grid.sync();

    {
        pg8::Gemm g{XB, WinT, T_ALL, QKV_COLS, DM, DM, DM}; pg8::StaticOrder S; S.init(T_ALL, QKV_COLS, G, bx);
        pg8::EpiQKV E{PA, PB, PC, PD, PE, PF, att::QSCALE, ctl};
        pg8::gemm_phase<pg8::EpiQKV, pg8::StaticOrder, true, true>(lds, g, S, E);
    }
    grid.sync();

    {
        float s1 = 0.f, s2 = 0.f;
        for (int i = 0; i < 64; ++i) { s1 += a.in[4][i] * a.in[5][i]; s2 += a.in[6][i] * a.in[7][i]; }
        const float lam = __expf(s1) - __expf(s2) + 0.2f;
        volatile LAS int* bcast = (volatile LAS int*)(lds + LDS_CTL);
        for (int qi = 0; qi < 8; ++qi) {
            const int x = (bx + qi) & 7;
            for (;;) {
                if (tid == 0) bcast[0] = (int)atomicAdd(ctl + 1024 + 64 * x, 1u);
                __syncthreads();
                const int i = __builtin_amdgcn_readfirstlane(bcast[0]);
                __syncthreads();
                if (i >= 768) break;
                const int si = i >> 5, w = i & 31, gi = si / 3, j = si - 3 * gi, h = 7 - gi, cs = (x + h) & 7;
                if (j == 0) { const int b = cs >> 2, part = cs & 3;
                    att::diff_unit(lds, PA, PB, PC, PA, (long)T_P + (long)b * 16384, 16384, h, part * 32 + w, lam, a.in[8], ctl + (8 + b) * 64); }
                else { const int cp = cs + 8 * (j - 1), b = cp >> 1, part = cp & 1;
                    att::diff_unit(lds, PA, PB, PC, PA, (long)b * 8192, 8192, h, part * 32 + w, lam, a.in[8], ctl + b * 64); }
            }
        }
        for (int it = vcu; it < 6144; it += G) {
            if (it < 4096) { const int b = it / (16 * 32), hq = (it / 32) % 16, qb = it % 32;
                att::win_unit(lds, PD, PE, PF, PD, (long)b * 8192, 8192, hq, qb, a.in[9]); }
            else { const int i2 = it - 4096; const int b = i2 / (16 * 64), hq = (i2 / 64) % 16, qb = i2 % 64;
                att::win_unit(lds, PD, PE, PF, PD, (long)T_P + (long)b * 16384, 16384, hq, qb, a.in[9]); }
        }
    }
    grid.sync();

    {
        pg8::Gemm g{XB, WinT + (size_t)QKV_COLS * DM, T_ALL, GATE_COLS, DM, DM, DM}; pg8::StaticOrder S; S.init(T_ALL, GATE_COLS, G, bx);
        pg8::EpiGate E{GM, a.in[3]};
        pg8::gemm_phase<pg8::EpiGate, pg8::StaticOrder, true, true>(lds, g, S, E);
    }
    grid.sync();

    {
        pg8::Gemm g{PA, WbraT, T_ALL, DM, DM, DM, DM}; pg8::StaticOrder S; S.init(T_ALL, DM, G, bx);
        pg8::EpiBranch<false> E{GM};
        pg8::gemm_phase<pg8::EpiBranch<false>, pg8::StaticOrder, true, true>(lds, g, S, E);
    }
    grid.sync();
    {
        pg8::Gemm g{PD, WbrbT, T_ALL, DM, DM, DM, DM}; pg8::StaticOrder S; S.init(T_ALL, DM, G, bx);
        pg8::EpiBranch<true> E{GM};
        pg8::gemm_phase<pg8::EpiBranch<true>, pg8::StaticOrder, true, true>(lds, g, S, E);
    }
    grid.sync();

    {
        pg8::Gemm g{GM, WoutT, T_ALL, DM, DM, 2048, DM}; pg8::StaticOrder S; S.init(T_ALL, DM, G, bx);
        pg8::EpiRes E{a.in[0], a.in[1], T_P, OUT, nullptr, DN_ALPHA};
        pg8::gemm_phase<pg8::EpiRes, pg8::StaticOrder, true, true>(lds, g, S, E);
    }
    grid.sync();

    ln_rows<true>(OUT, X1B, a.in[13], a.in[14], gw, NGW, lane);
    grid.sync();

    {
        pg8::Gemm g{X1B, Wff1T, T_ALL, DFF, DM, DM, DM}; pg8::StaticOrder S; S.init(T_ALL, DFF, G, bx);
        pg8::EpiFF1 E{HB, a.in[16]};
        pg8::gemm_phase<pg8::EpiFF1, pg8::StaticOrder, true, true>(lds, g, S, E);
    }
    grid.sync();

    {
        pg8::Gemm g{HB, Wff2T, T_ALL, DM, DFF, DFF, DFF}; pg8::StaticOrder S; S.init(T_ALL, DM, G, bx);
        pg8::EpiRes E{OUT, OUT, 1 << 30, OUT, a.in[18], DN_ALPHA};
        pg8::gemm_phase<pg8::EpiRes, pg8::StaticOrder, true, true>(lds, g, S, E);
    }
    grid.sync();

    ln_rows<false>(OUT, nullptr, a.in[19], a.in[20], gw, NGW, lane);
}

extern "C" void kernel_launch(void* const* d_in, const int* in_sizes, int n_in, void* d_out, int out_size, void* d_ws, size_t ws_size, hipStream_t stream) {
    static int grid = 0;
    if (grid == 0) {
        if (n_in != 21 || out_size != T_ALL * DM || ws_size < WS_END) { fprintf(stderr, "kernel_launch: unexpected shapes (n_in %d, out %d, ws %zu < %zu)\n", n_in, out_size, ws_size, (size_t)WS_END); grid = -1; return; }
        int dev = 0, cus = 0, per_cu = 0;
        (void)hipGetDevice(&dev);
        (void)hipDeviceGetAttribute(&cus, hipDeviceAttributeMultiprocessorCount, dev);
        (void)hipFuncSetAttribute((const void*)fwd_megakernel, hipFuncAttributeMaxDynamicSharedMemorySize, LDS_BYTES);
        if (hipOccupancyMaxActiveBlocksPerMultiprocessor(&per_cu, (const void*)fwd_megakernel, NWAVES * 64, LDS_BYTES) != hipSuccess || per_cu < 1) per_cu = 1;
        (void)hipGetLastError();
        if (cus <= 0) cus = 256;
        grid = cus * per_cu;
    }
    if (grid < 0) return;
    Args a{};
    for (int i = 0; i < 21; ++i) a.in[i] = (const float*)d_in[i];
    a.out = (float*)d_out; a.ws = (unsigned char*)d_ws;
    void* args[] = {&a};
    hipError_t e = hipLaunchCooperativeKernel((const void*)fwd_megakernel, dim3(grid), dim3(NWAVES * 64), args, LDS_BYTES, stream);
    if (e != hipSuccess) fprintf(stderr, "cooperative launch failed: %s (grid %d)\n", hipGetErrorString(e), grid);
}
```

```cpp
#include <hip/hip_runtime.h>
#include <hip/hip_cooperative_groups.h>
#include <cstdio>
#include <cstdint>
namespace cg = cooperative_groups;

namespace pg8 {
#define PG8_LAS __attribute__((address_space(3)))
typedef unsigned short bf16_t;
typedef short bf16x8 __attribute__((ext_vector_type(8)));
typedef float f32x4 __attribute__((ext_vector_type(4)));
typedef unsigned u32x4 __attribute__((ext_vector_type(4)));
constexpr int BM = 256, BK = 64, HALF = 128, HTB = HALF * BK * 2  , STAGE_BYTES = 8 * HTB, NXCD = 8, WGM = 8;

__host__ __device__ __forceinline__ int lds_byte(int r, int c) { const int st = (r >> 4) * 2 + (c >> 5), rr = r & 15, cc = c & 31, ob = rr * 64 + cc * 2; return st * 1024 + (ob ^ (((ob >> 9) & 1) << 5)); }
__host__ __device__ __forceinline__ void stage_rc(int b, int& R, int& C) { const int st = b / 1024, sb = b % 1024, swz = sb ^ (((sb >> 9) & 1) << 5); R = (st >> 1) * 16 + swz / 64; C = (st & 1) * 32 + (swz % 64) / 2; }
__host__ __device__ __forceinline__ int perm32(int rho) { const int n = rho >> 4, i = rho & 15; return 8 * (i >> 2) + 4 * n + (i & 3); }

struct Unit { int pm, pn; };
struct Gemm { const bf16_t* A; const bf16_t* Bt; int M, N, K, lda, ldb; };

struct StaticOrder {
    int nM, nN, nwg, G, c;
    __host__ __device__ void init(int M, int N, int G_, int c_) { nM = M / BM; nN = N / BM; nwg = nM * nN; G = G_; c = c_; }
    __host__ __device__ bool next(int i, Unit& u) const {
        const long L = (long)i * G + c; if (L >= nwg) return false;
        int wgid = (int)L; { const int q = nwg / NXCD, r = nwg % NXCD, xcd = wgid % NXCD, off = wgid / NXCD; wgid = (xcd < r ? xcd * (q + 1) : r * (q + 1) + (xcd - r) * q) + off; }
        const int nig = WGM * nN, gid = wgid / nig, fm = gid * WGM, gsz = (nM - fm) < WGM ? (nM - fm) : WGM;
        u.pm = fm + ((wgid % nig) % gsz); u.pn = (wgid % nig) / gsz; return true;
    }
    __device__ __forceinline__ void a_ready(const Unit&) const {}
    __device__ __forceinline__ void done(const Unit&) const {}
};

typedef __bf16 bf16x2_t __attribute__((ext_vector_type(2)));
typedef float f32x2_t __attribute__((ext_vector_type(2)));
__device__ __forceinline__ unsigned pk_bf16(float lo, float hi) { f32x2_t v = {lo, hi}; bf16x2_t b = __builtin_convertvector(v, bf16x2_t); return __builtin_bit_cast(unsigned, b); }
__device__ __forceinline__ float bf_lo(unsigned w) { return __uint_as_float(w << 16); }
__device__ __forceinline__ float bf_hi(unsigned w) { return __uint_as_float(w & 0xffff0000u); }
__device__ __forceinline__ u32x4 pack8(const f32x4 a, const f32x4 b) { u32x4 w; w.x = pk_bf16(a[0], a[1]); w.y = pk_bf16(a[2], a[3]); w.z = pk_bf16(b[0], b[1]); w.w = pk_bf16(b[2], b[3]); return w; }
#define PG8_ROWFENCE() asm volatile("" ::: "memory")

struct EpiQKV {
    static constexpr bool PERM = true, AFTER_DRAIN = false;
    bf16_t *PA, *PB, *PC, *PD, *PE, *PF; float qscale; unsigned* stats;
    __device__ __forceinline__ void operator()(const f32x4 (&acc)[2][2][4][2], const Unit& u, int wr, int wc, int fr, int fq) const {
        const int pn = u.pn; bf16_t* base; int ld = 1024, cb; float sc = 1.f;
        if (pn < 8) {
            const float s0 = pn < 4 ? qscale : 1.f; float rmax[2] = {0.f, 0.f};
#pragma unroll
            for (int ai = 0; ai < 2; ++ai)
#pragma unroll
                for (int m = 0; m < 4; ++m)
#pragma unroll
                    for (int bj = 0; bj < 2; ++bj) { const f32x4 a = acc[ai][bj][m][0] * s0, b = acc[ai][bj][m][1] * s0;
                        float q = (a[0] * a[0] + a[1] * a[1]) + (a[2] * a[2] + a[3] * a[3]) + (b[0] * b[0] + b[1] * b[1]) + (b[2] * b[2] + b[3] * b[3]);
                        q += __shfl_xor(q, 16); q += __shfl_xor(q, 32); rmax[bj] = fmaxf(rmax[bj], q); }
#pragma unroll
            for (int bj = 0; bj < 2; ++bj) { float q = rmax[bj];
                q = fmaxf(q, __shfl_xor(q, 1)); q = fmaxf(q, __shfl_xor(q, 2)); q = fmaxf(q, __shfl_xor(q, 4)); q = fmaxf(q, __shfl_xor(q, 8));
                const int rowt = u.pm * BM, seq = rowt < 65536 ? (rowt >> 13) : 8 + ((rowt - 65536) >> 14);
                if (fr == 0 && fq == 0) atomicMax(stats + (seq * 2 + (pn >> 2)) * 32 + (pn & 3) * 8 + bj * 4 + wc, __float_as_uint(q)); }
        }
        if (pn < 4) { base = PA; cb = pn * 256; sc = qscale; }
        else if (pn < 8) { base = PB; cb = (pn - 4) * 256; }
        else if (pn < 12) { base = PC; cb = (pn - 8) * 256; }
        else if (pn < 16) { base = PD; cb = (pn - 12) * 256; sc = qscale; }
        else if (pn == 16) { base = PE; ld = 256; cb = 0; }
        else { base = PF; ld = 256; cb = 0; }
        const int row0 = u.pm * BM + wr * 64 + fr, col0 = cb + wc * 32 + 8 * fq;
#pragma unroll
        for (int ai = 0; ai < 2; ++ai)
#pragma unroll
            for (int m = 0; m < 4; ++m) { bf16_t* rowp = base + (size_t)(row0 + ai * HALF + m * 16) * ld + col0;
#pragma unroll
                for (int bj = 0; bj < 2; ++bj) *(u32x4*)(rowp + bj * HALF) = pack8(acc[ai][bj][m][0] * sc, acc[ai][bj][m][1] * sc); }
    }
};
struct EpiGate {
    static constexpr bool PERM = true, AFTER_DRAIN = false;
    bf16_t* G; const float* bias;
    __device__ __forceinline__ void operator()(const f32x4 (&acc)[2][2][4][2], const Unit& u, int wr, int wc, int fr, int fq) const {
        const int row0 = u.pm * BM + wr * 64 + fr, col0 = u.pn * BM + wc * 32 + 8 * fq;
        f32x4 bv[2][2];
#pragma unroll
        for (int bj = 0; bj < 2; ++bj)
#pragma unroll
            for (int n = 0; n < 2; ++n) bv[bj][n] = *(const f32x4*)(bias + col0 + bj * HALF + 4 * n);
#pragma unroll
        for (int ai = 0; ai < 2; ++ai)
#pragma unroll
            for (int m = 0; m < 4; ++m) { bf16_t* rowp = G + (size_t)(row0 + ai * HALF + m * 16) * 2048 + col0;
#pragma unroll
                for (int bj = 0; bj < 2; ++bj) { f32x4 v0 = acc[ai][bj][m][0] + bv[bj][0], v1 = acc[ai][bj][m][1] + bv[bj][1];
#pragma unroll
                    for (int e = 0; e < 4; ++e) { v0[e] = __builtin_amdgcn_rcpf(1.f + __expf(-v0[e])); v1[e] = __builtin_amdgcn_rcpf(1.f + __expf(-v1[e])); }
                    *(u32x4*)(rowp + bj * HALF) = pack8(v0, v1); } }
    }
};
template <bool SECOND> struct EpiBranch {
    static constexpr bool PERM = true, AFTER_DRAIN = false;
    bf16_t* G;
    __device__ __forceinline__ void operator()(const f32x4 (&acc)[2][2][4][2], const Unit& u, int wr, int wc, int fr, int fq) const {
        const int row0 = u.pm * BM + wr * 64 + fr, col0 = u.pn * BM + wc * 32 + 8 * fq;
#pragma unroll
        for (int ai = 0; ai < 2; ++ai)
#pragma unroll
            for (int m = 0; m < 4; ++m) { bf16_t* rowp = G + (size_t)(row0 + ai * HALF + m * 16) * 2048 + col0;
#pragma unroll
                for (int bj = 0; bj < 2; ++bj) {
                    const u32x4 gw = *(const u32x4*)(rowp + bj * HALF + (SECOND ? 1024 : 0));
                    const f32x4 a0 = acc[ai][bj][m][0], a1 = acc[ai][bj][m][1];
                    f32x4 v0 = {bf_lo(gw.x) * a0[0], bf_hi(gw.x) * a0[1], bf_lo(gw.y) * a0[2], bf_hi(gw.y) * a0[3]};
                    f32x4 v1 = {bf_lo(gw.z) * a1[0], bf_hi(gw.z) * a1[1], bf_lo(gw.w) * a1[2], bf_hi(gw.w) * a1[3]};
                    if (SECOND) { const u32x4 pw = *(const u32x4*)(rowp + bj * HALF);
                        v0 += (f32x4){bf_lo(pw.x), bf_hi(pw.x), bf_lo(pw.y), bf_hi(pw.y)}; v1 += (f32x4){bf_lo(pw.z), bf_hi(pw.z), bf_lo(pw.w), bf_hi(pw.w)}; }
                    *(u32x4*)(rowp + bj * HALF) = pack8(v0, v1); }
                PG8_ROWFENCE(); }
    }
};
struct EpiFF1 {
    static constexpr bool PERM = true, AFTER_DRAIN = false;
    bf16_t* H; const float* bias;
    __device__ __forceinline__ void operator()(const f32x4 (&acc)[2][2][4][2], const Unit& u, int wr, int wc, int fr, int fq) const {
        const int row0 = u.pm * BM + wr * 64 + fr, col0 = u.pn * BM + wc * 32 + 8 * fq;
        f32x4 bv[2][2];
#pragma unroll
        for (int bj = 0; bj < 2; ++bj)
#pragma unroll
            for (int n = 0; n < 2; ++n) bv[bj][n] = *(const f32x4*)(bias + col0 + bj * HALF + 4 * n);
#pragma unroll
        for (int ai = 0; ai < 2; ++ai)
#pragma unroll
            for (int m = 0; m < 4; ++m) { bf16_t* rowp = H + (size_t)(row0 + ai * HALF + m * 16) * 4096 + col0;
#pragma unroll
                for (int bj = 0; bj < 2; ++bj) { f32x4 v0 = acc[ai][bj][m][0] + bv[bj][0], v1 = acc[ai][bj][m][1] + bv[bj][1];
#pragma unroll
                    for (int e = 0; e < 4; ++e) { v0[e] = fmaxf(v0[e], 0.f); v1[e] = fmaxf(v1[e], 0.f); }
                    *(u32x4*)(rowp + bj * HALF) = pack8(v0 * v0, v1 * v1); } }
    }
};
struct EpiRes {
    static constexpr bool PERM = false, AFTER_DRAIN = false;
    const float* resA; const float* resB; int splitRow; float* out; const float* bias; float alpha;
    __device__ __forceinline__ void operator()(const f32x4 (&acc)[2][2][4][2], const Unit& u, int wr, int wc, int fr, int fq) const {
        const int rowt = u.pm * BM; const int col0 = u.pn * BM + wc * 32 + 4 * fq;
        const float* rbase = rowt < splitRow ? resA + (size_t)rowt * 1024 : resB + (size_t)(rowt - splitRow) * 1024;
        float* obase = out + (size_t)rowt * 1024;
        f32x4 bv[2][2];
#pragma unroll
        for (int bj = 0; bj < 2; ++bj)
#pragma unroll
            for (int n = 0; n < 2; ++n) bv[bj][n] = bias ? *(const f32x4*)(bias + col0 + bj * HALF + n * 16) : (f32x4){0.f, 0.f, 0.f, 0.f};
#pragma unroll
        for (int ai = 0; ai < 2; ++ai)
#pragma unroll
            for (int m = 0; m < 4; ++m) { const size_t off = (size_t)(wr * 64 + fr + ai * HALF + m * 16) * 1024 + col0;
#pragma unroll
                for (int bj = 0; bj < 2; ++bj)
#pragma unroll
                    for (int n = 0; n < 2; ++n) { const f32x4 x = *(const f32x4*)(rbase + off + bj * HALF + n * 16);
                        *(f32x4*)(obase + off + bj * HALF + n * 16) = x * alpha + acc[ai][bj][m][n] + bv[bj][n]; }
                PG8_ROWFENCE(); }
    }
};

template <class Epi, class Sched, bool ALIGN_EPI = false, bool SP2 = false>
__device__ __forceinline__ void gemm_phase(PG8_LAS unsigned char* lds, const Gemm g, const Sched& S, const Epi& E) {
    int tid_ = threadIdx.x; asm volatile("" : "+v"(tid_));
    const int tid = tid_, wid = __builtin_amdgcn_readfirstlane(tid >> 6), lane = tid & 63, wr = wid >> 2, wc = wid & 3, fr = lane & 15, fq = lane >> 4;
    const int K = g.K, nt = K / BK;
    unsigned voffA[2], voffB[2];
#pragma unroll
    for (int i = 0; i < 2; ++i) { int R, C; stage_rc(tid * 16 + i * 8192, R, C); const int Rb = Epi::PERM ? ((R & ~31) + perm32(R & 31)) : R;
        voffA[i] = (unsigned)(R * g.lda + C) * 2u; voffB[i] = (unsigned)(Rb * g.ldb + C) * 2u; }
    const size_t kstep = (size_t)(BK * 2);
    const size_t hstepA = (size_t)HALF * g.lda * 2, hstepB = (size_t)HALF * g.ldb * 2;
    const size_t tstepA = 2 * hstepA, tstepB = 2 * hstepB;
    const unsigned ldsw = (unsigned)wid * 1024u;
    const int aoff = lds_byte(wr * 64 + fr, fq * 8), boff = lds_byte(wc * 32 + fr, fq * 8);
#define PG8_SA(b, h) (((b) * 2 + (h)) * HTB)
#define PG8_SB(b, h) ((4 + (b) * 2 + (h)) * HTB)
#define PG8_STAGE(bufoff, gbase, voff) do { _Pragma("unroll") for (int _i = 0; _i < 2; ++_i) \
        __builtin_amdgcn_global_load_lds((const unsigned*)((const char*)(gbase) + (voff)[_i]), (PG8_LAS unsigned*)(lds + (bufoff) + ldsw + _i * 8192), 16, 0, 0); } while (0)
#define PG8_LDA(dst, b, h) do { _Pragma("unroll") for (int m = 0; m < 4; ++m) _Pragma("unroll") for (int k = 0; k < 2; ++k) dst[m][k] = *(const PG8_LAS bf16x8*)(lds + PG8_SA(b, h) + aoff + m * 2048 + k * 1024); } while (0)
#define PG8_LDB(dst, b, h) do { _Pragma("unroll") for (int n = 0; n < 2; ++n) _Pragma("unroll") for (int k = 0; k < 2; ++k) dst[n][k] = *(const PG8_LAS bf16x8*)(lds + PG8_SB(b, h) + boff + n * 2048 + k * 1024); } while (0)
#define PG8_MMA(ai, bj, At, Bt) do { __builtin_amdgcn_s_setprio(1); _Pragma("unroll") for (int m = 0; m < 4; ++m) _Pragma("unroll") for (int n = 0; n < 2; ++n) _Pragma("unroll") for (int k = 0; k < 2; ++k) \
        acc[ai][bj][m][n] = __builtin_amdgcn_mfma_f32_16x16x32_bf16(Bt[n][k], At[m][k], acc[ai][bj][m][n], 0, 0, 0); __builtin_amdgcn_s_setprio(0); } while (0)
#define PG8_WAIT_V(n) asm volatile("s_waitcnt vmcnt(" #n ")" ::: "memory")
#define PG8_WAIT_L(n) asm volatile("s_waitcnt lgkmcnt(" #n ")" ::: "memory")
#define PG8_BAR __builtin_amdgcn_s_barrier()
#define PG8_SCHED __builtin_amdgcn_sched_barrier(0)
    Unit cur, nxt; int ui = 0;
    if (!S.next(0, cur)) return;
    f32x4 acc[2][2][4][2];
#pragma unroll
    for (int a = 0; a < 2; ++a)
#pragma unroll
        for (int b = 0; b < 2; ++b)
#pragma unroll
            for (int m = 0; m < 4; ++m)
#pragma unroll
                for (int n = 0; n < 2; ++n) acc[a][b][m][n] = (f32x4){0.f, 0.f, 0.f, 0.f};
    bf16x8 At[4][2], B0[2][2], B1[2][2];
    const char* cA = (const char*)g.A + (size_t)cur.pm * tstepA; const char* cB = (const char*)g.Bt + (size_t)cur.pn * tstepB;
    S.a_ready(cur);
    if constexpr (SP2) {
        PG8_STAGE(PG8_SB(0, 0), cB, voffB); PG8_STAGE(PG8_SB(0, 1), cB + hstepB, voffB); PG8_STAGE(PG8_SA(0, 0), cA, voffA); PG8_STAGE(PG8_SA(0, 1), cA + hstepA, voffA);
        if (wr == 1) PG8_BAR;
        PG8_WAIT_V(2); PG8_BAR;
        PG8_STAGE(PG8_SB(1, 0), cB + kstep, voffB); PG8_STAGE(PG8_SA(1, 0), cA + kstep, voffA); PG8_STAGE(PG8_SB(1, 1), cB + hstepB + kstep, voffB);
        PG8_WAIT_V(6); PG8_BAR;
    } else {
        PG8_STAGE(PG8_SB(0, 0), cB, voffB); PG8_STAGE(PG8_SA(0, 0), cA, voffA); PG8_STAGE(PG8_SB(0, 1), cB + hstepB, voffB); PG8_STAGE(PG8_SA(0, 1), cA + hstepA, voffA);
        if (wr == 1) PG8_BAR;
        PG8_WAIT_V(4); PG8_BAR;
        PG8_STAGE(PG8_SB(1, 0), cB + kstep, voffB); PG8_STAGE(PG8_SA(1, 0), cA + kstep, voffA); PG8_STAGE(PG8_SB(1, 1), cB + hstepB + kstep, voffB);
        PG8_WAIT_V(6); PG8_BAR;
    }
    for (;;) {
        const bool has_next = S.next(ui + 1, nxt);
        const char* nA = has_next ? (const char*)g.A + (size_t)nxt.pm * tstepA : cA; const char* nB = has_next ? (const char*)g.Bt + (size_t)nxt.pn * tstepB : cB;
        for (int t = 0; t < nt; t += 2) {
            const bool last = (t == nt - 2);
            const char* a1 = cA + (size_t)(t + 1) * kstep;
            const char* a2 = last ? nA : cA + (size_t)(t + 2) * kstep; const char* b2 = last ? nB : cB + (size_t)(t + 2) * kstep;
            const char* a3 = a2 + kstep; const char* b3 = b2 + kstep;
            if (last && has_next) S.a_ready(nxt);
            if constexpr (SP2) {
            PG8_LDB(B0, 0, 0); PG8_LDB(B1, 0, 1); PG8_SCHED; PG8_LDA(At, 0, 0); PG8_STAGE(PG8_SA(1, 1), a1 + hstepA, voffA);
            PG8_WAIT_V(8); PG8_WAIT_L(0); PG8_BAR; PG8_MMA(0, 0, At, B0); PG8_MMA(0, 1, At, B1); PG8_BAR; PG8_SCHED;
            PG8_LDA(At, 0, 1); PG8_STAGE(PG8_SB(0, 0), b2, voffB); PG8_STAGE(PG8_SB(0, 1), b2 + hstepB, voffB); PG8_STAGE(PG8_SA(0, 0), a2, voffA);
            PG8_WAIT_V(8); PG8_WAIT_L(0); PG8_BAR; PG8_MMA(1, 0, At, B0); PG8_MMA(1, 1, At, B1); PG8_BAR; PG8_SCHED;
            PG8_LDB(B0, 1, 0); PG8_LDB(B1, 1, 1); PG8_SCHED; PG8_LDA(At, 1, 0); PG8_STAGE(PG8_SA(0, 1), a2 + hstepA, voffA);
            PG8_WAIT_V(8); PG8_WAIT_L(0); PG8_BAR; PG8_MMA(0, 0, At, B0); PG8_MMA(0, 1, At, B1); PG8_BAR; PG8_SCHED;
            PG8_LDA(At, 1, 1); PG8_STAGE(PG8_SB(1, 0), b3, voffB); PG8_STAGE(PG8_SB(1, 1), b3 + hstepB, voffB); PG8_STAGE(PG8_SA(1, 0), a3, voffA);
            PG8_WAIT_V(8); PG8_WAIT_L(0); PG8_BAR; PG8_MMA(1, 0, At, B0); PG8_MMA(1, 1, At, B1); PG8_BAR; PG8_SCHED;
            } else {
            PG8_LDB(B0, 0, 0); PG8_SCHED; PG8_LDA(At, 0, 0); PG8_STAGE(PG8_SA(1, 1), a1 + hstepA, voffA);
            PG8_WAIT_L(8); PG8_BAR; PG8_WAIT_L(0); PG8_MMA(0, 0, At, B0); PG8_BAR; PG8_SCHED;
            PG8_LDB(B1, 0, 1); PG8_STAGE(PG8_SB(0, 0), b2, voffB);
            PG8_BAR; PG8_WAIT_L(0); PG8_MMA(0, 1, At, B1); PG8_BAR;
            PG8_LDA(At, 0, 1); PG8_STAGE(PG8_SA(0, 0), a2, voffA);
            PG8_BAR; PG8_WAIT_L(0); PG8_MMA(1, 0, At, B0); PG8_BAR; PG8_SCHED;
            PG8_STAGE(PG8_SB(0, 1), b2 + hstepB, voffB);
            PG8_WAIT_V(6); PG8_BAR; PG8_MMA(1, 1, At, B1); PG8_BAR;
            PG8_LDB(B0, 1, 0); PG8_SCHED; PG8_LDA(At, 1, 0); PG8_STAGE(PG8_SA(0, 1), a2 + hstepA, voffA);
            PG8_WAIT_L(8); PG8_BAR; PG8_WAIT_L(0); PG8_MMA(0, 0, At, B0); PG8_BAR; PG8_SCHED;
            PG8_LDB(B1, 1, 1); PG8_STAGE(PG8_SB(1, 0), b3, voffB);
            PG8_BAR; PG8_WAIT_L(0); PG8_MMA(0, 1, At, B1); PG8_BAR;
            PG8_LDA(At, 1, 1); PG8_STAGE(PG8_SA(1, 0), a3, voffA);
            PG8_BAR; PG8_WAIT_L(0); PG8_MMA(1, 0, At, B0); PG8_BAR; PG8_SCHED;
            PG8_STAGE(PG8_SB(1, 1), b3 + hstepB, voffB);
            PG8_WAIT_V(6); PG8_BAR; PG8_MMA(1, 1, At, B1); PG8_BAR;
            }
        }
        if constexpr (ALIGN_EPI) { if (wr == 0) PG8_BAR; }
        if constexpr (!Epi::AFTER_DRAIN) { E(acc, cur, wr, wc, fr, fq); S.done(cur); }
        if (!has_next) break;
#pragma unroll
        for (int a = 0; a < 2; ++a)
#pragma unroll
            for (int b = 0; b < 2; ++b)
#pragma unroll
                for (int m = 0; m < 4; ++m)
#pragma unroll
                    for (int n = 0; n < 2; ++n) acc[a][b][m][n] = (f32x4){0.f, 0.f, 0.f, 0.f};
        cur = nxt; cA = nA; cB = nB; ++ui;
        if constexpr (ALIGN_EPI) { if (wr == 1) PG8_BAR; }
    }
    PG8_WAIT_V(0);
    if constexpr (!ALIGN_EPI) { if (wr == 0) PG8_BAR; }
    PG8_BAR;
    if constexpr (Epi::AFTER_DRAIN) { E.fused(acc, cur, wr, wc, fr, fq, lds, wid, lane); S.done(cur); }
#undef PG8_SA
#undef PG8_SB
#undef PG8_STAGE
#undef PG8_LDA
#undef PG8_LDB
#undef PG8_MMA
#undef PG8_WAIT_V
#undef PG8_WAIT_L
#undef PG8_BAR
#undef PG8_SCHED
}
}

namespace att {
#define ATT_LAS __attribute__((address_space(3)))
typedef unsigned short bf16_t;
typedef short bf16x8 __attribute__((ext_vector_type(8)));
typedef short s16x4 __attribute__((ext_vector_type(4)));
typedef float f32x16 __attribute__((ext_vector_type(16)));
typedef unsigned u32x4 __attribute__((ext_vector_type(4)));
typedef unsigned u32x2 __attribute__((ext_vector_type(2)));
typedef ATT_LAS unsigned char* ldsp;
constexpr float LOG2E = 1.4426950408889634f;
constexpr float QSCALE = 0.125f * LOG2E;
constexpr float LN_EPS = 1e-5f;
#define ATT_MFMA(a, b, c) __builtin_amdgcn_mfma_f32_32x32x16_bf16((a), (b), (c), 0, 0, 0)
__device__ __forceinline__ s16x4 vtr(ldsp p) { return __builtin_bit_cast(s16x4, __builtin_amdgcn_ds_read_tr16_b64_v4i16((ATT_LAS s16x4*)p)); }
__device__ __forceinline__ bf16x8 pack_frag(const f32x16& x, int s8) {
    u32x4 p; p.x = pg8::pk_bf16(x[s8], x[s8 + 1]); p.y = pg8::pk_bf16(x[s8 + 2], x[s8 + 3]); p.z = pg8::pk_bf16(x[s8 + 4], x[s8 + 5]); p.w = pg8::pk_bf16(x[s8 + 6], x[s8 + 7]);
    return __builtin_bit_cast(bf16x8, p);
}
__device__ __forceinline__ int voff(int key, int ch  ) { return (ch >> 2) * 4096 + (key >> 4) * 1024 + ((key >> 3) & 1) * 512 + (key & 7) * 64 + (ch & 3) * 16; }

constexpr int DKP = 272;
constexpr int DKBUF = 64 * DKP, DVBUF = 64 * 256, DBUF = DKBUF + DVBUF;
constexpr int DXOFF = 2 * DBUF;
constexpr int D_LDS = DXOFF + 65536;

__device__ __forceinline__ void diff_unit(ldsp lds, const bf16_t* Qp, const bf16_t* Kp, const bf16_t* Vp, bf16_t* Op,
                                          long rowbase, int S, int h, int qblk, float lam, const float* __restrict__ subln_g, const unsigned* stats  ) {
    int tid_ = threadIdx.x; asm volatile("" : "+v"(tid_));
    const int tid = tid_, lane = tid & 63, r = lane & 31, hh = lane >> 5;
    const int wid = __builtin_amdgcn_readfirstlane(tid >> 6), c = wid >> 2, qsub = wid & 3;
    const int q0 = qblk * 128, qpos = q0 + qsub * 32 + r;
    const float nslope2 = -LOG2E * __builtin_amdgcn_exp2f(-(float)(h + 1));
    bf16x8 qf[4];
    { const bf16_t* qptr = Qp + (size_t)(rowbase + qpos) * 1024 + h * 128 + c * 64 + hh * 8;
#pragma unroll
      for (int ks = 0; ks < 4; ++ks) qf[ks] = *(const bf16x8*)(qptr + ks * 16); }
    const int skey = tid >> 4, sch = tid & 15;
    const bf16_t* kg = Kp + (size_t)(rowbase + skey) * 1024 + h * 128 + sch * 8;
    const bf16_t* vg = Vp + (size_t)(rowbase + skey) * 1024 + h * 128 + sch * 8;
    const int NT = S / 64;
    int tlo, thi; bool fast;
    { float b2 = 0.f;
#pragma unroll
      for (int cc = 0; cc < 2; ++cc) { const float qn = __uint_as_float(stats[h * 4 + cc * 2]) + __uint_as_float(stats[h * 4 + cc * 2 + 1]);
          const float kn = __uint_as_float(stats[32 + h * 4 + cc * 2]) + __uint_as_float(stats[32 + h * 4 + cc * 2 + 1]); b2 = fmaxf(b2, qn * kn); }
      const float B = 1.02f * sqrtf(b2); fast = __builtin_amdgcn_readfirstlane((int)(B <= 60.f)) != 0;
      float dcf = (80.f + 2.f * B) / (-nslope2) + 2.f; if (!(dcf < (float)S)) dcf = (float)S;
      const int dc = (int)dcf; const int lo = q0 - dc, hi2 = q0 + 127 + dc;
      tlo = lo <= 0 ? 0 : (lo >> 6); thi = (hi2 >> 6) > NT - 1 ? NT - 1 : (hi2 >> 6);
      tlo = __builtin_amdgcn_readfirstlane(tlo); thi = __builtin_amdgcn_readfirstlane(thi); }
    const int kl0r = skey * DKP + sch * 16, kl1r = (skey + 32) * DKP + sch * 16, vl0r = voff(skey, sch), vl1r = voff(skey + 32, sch);
    float l = 0.f;
    f32x16 o[4];
#pragma unroll
    for (int eb = 0; eb < 4; ++eb)
#pragma unroll
        for (int i = 0; i < 16; ++i) o[eb][i] = 0.f;
    const int kread = r * DKP + c * 128 + hh * 16;
    const int vreadr = (4 * hh + ((lane & 15) >> 2)) * 64 + ((lane >> 4) & 1) * 32 + (lane & 3) * 8;
    if (fast) {
        const float slope2 = -nslope2; const int qw0 = q0 + qsub * 32;
        typedef float f32x2 __attribute__((ext_vector_type(2)));
        constexpr int RK = 0, RV = 65536, RS = 16384;
        const int krow = 4 * wid + (lane >> 4);
        const bf16_t* kgd = Kp + (size_t)(rowbase + krow) * 1024 + h * 128 + (((lane & 15) ^ (krow & 15)) * 8);
        const bf16_t* vgd = Vp + (size_t)(rowbase + 16 * (wid & 3) + (lane >> 2)) * 1024 + h * 128 + ((wid >> 2) * 4 + (lane & 3)) * 8;
#define DF_DMA(g, l) __builtin_amdgcn_global_load_lds((const unsigned*)(g), (ATT_LAS unsigned*)(l), 16, 0, 0)
#define DF_DMAK(tt, slot) do { const bf16_t* g_ = kgd + (size_t)(tt) * 64 * 1024; const ldsp l_ = lds + RK + (slot) * RS + wid * 1024; DF_DMA(g_, l_); DF_DMA(g_ + 32 * 1024, l_ + 8192); } while (0)
#define DF_DMAV(tt, slot) do { const bf16_t* g_ = vgd + (size_t)(tt) * 64 * 1024; const ldsp l_ = lds + RV + (slot) * RS + wid * 1024; DF_DMA(g_, l_); DF_DMA(g_ + 64, l_ + 8192); } while (0)
#define DF_CF(i) ((float)(((i) & 3) + 8 * ((i) >> 2)))
#define DF_INIT(S0, S1, tt) do { const int tb_ = (tt) * 64; const float db_ = (float)(tb_ + 4 * hh - qpos); \
        if (tb_ + 63 < qw0 || tb_ > qw0 + 31) { const float a_ = (tb_ + 63 < qw0) ? slope2 : -slope2, bl_ = a_ * db_;   \
            _Pragma("unroll") for (int i = 0; i < 16; ++i) { S0[i] = __builtin_fmaf(a_, DF_CF(i), bl_); S1[i] = __builtin_fmaf(a_, DF_CF(i) + 32.f, bl_); } } \
        else { _Pragma("unroll") for (int i = 0; i < 16; ++i) { S0[i] = nslope2 * __builtin_fabsf(db_ + DF_CF(i)); S1[i] = nslope2 * __builtin_fabsf(db_ + DF_CF(i) + 32.f); } } } while (0)
#define DF_VLOAD(ARR, vb, eb) do { _Pragma("unroll") for (int kk = 0; kk < 4; ++kk) { const s16x4 lo_ = vtr((vb) + (eb) * 4096 + kk * 1024), hi_ = vtr((vb) + (eb) * 4096 + kk * 1024 + 512); \
        ARR[kk] = __builtin_shufflevector(lo_, hi_, 0, 1, 2, 3, 4, 5, 6, 7); } } while (0)
#define DF_SB() __builtin_amdgcn_sched_barrier(0)
#define DF_CL(tt) ((tt) < thi ? (tt) : thi)
        f32x2 l2 = {0.f, 0.f};
        const int n = thi - tlo + 1;
        int koff[4];
#pragma unroll
        for (int ks = 0; ks < 4; ++ks) koff[ks] = r * 256 + (((c * 8 + 2 * ks + hh) ^ (r & 15)) << 4);
        DF_DMAK(tlo, 0); DF_DMAV(tlo, 3);
        DF_DMAK(DF_CL(tlo + 1), 1); DF_DMAV(tlo, 0);
        DF_DMAK(DF_CL(tlo + 2), 2); DF_DMAV(DF_CL(tlo + 1), 1);
        f32x16 s0, s1; bf16x8 pf[4];
#pragma unroll
        for (int kk = 0; kk < 4; ++kk) pf[kk] = (bf16x8){0, 0, 0, 0, 0, 0, 0, 0};
        for (int j = 0; j < n; ++j) {
            const int T = tlo + j;
            asm volatile("s_waitcnt vmcnt(8)" ::: "memory"); __builtin_amdgcn_s_barrier(); asm volatile("" ::: "memory");
            DF_DMAK(DF_CL(T + 3), (j + 3) & 3); DF_DMAV(DF_CL(T + 2), (j + 2) & 3);
            DF_INIT(s0, s1, T);
            const ldsp kb_ = lds + RK + (j & 3) * RS;
            const ldsp vb_ = lds + RV + ((j + 3) & 3) * RS + vreadr;
            bf16x8 kf[8], vA[4], vB[4];
#pragma unroll
            for (int ks = 0; ks < 4; ++ks) { kf[2 * ks] = *(const ATT_LAS bf16x8*)(kb_ + koff[ks]); kf[2 * ks + 1] = *(const ATT_LAS bf16x8*)(kb_ + koff[ks] + 8192); }
            DF_VLOAD(vA, vb_, 0);
            DF_SB();
#pragma unroll
            for (int ks = 0; ks < 4; ++ks) { s0 = ATT_MFMA(kf[2 * ks], qf[ks], s0); s1 = ATT_MFMA(kf[2 * ks + 1], qf[ks], s1); }
            DF_VLOAD(vB, vb_, 1);
            DF_SB();
#pragma unroll
            for (int kk = 0; kk < 4; ++kk) o[0] = ATT_MFMA(vA[kk], pf[kk], o[0]);
#pragma unroll
            for (int i = 0; i < 8; ++i) s0[i] = __builtin_amdgcn_exp2f(s0[i]);
            DF_VLOAD(vA, vb_, 2);
            DF_SB();
#pragma unroll
            for (int kk = 0; kk < 4; ++kk) o[1] = ATT_MFMA(vB[kk], pf[kk], o[1]);
#pragma unroll
            for (int i = 8; i < 16; ++i) s0[i] = __builtin_amdgcn_exp2f(s0[i]);
            DF_VLOAD(vB, vb_, 3);
            DF_SB();
#pragma unroll
            for (int kk = 0; kk < 4; ++kk) o[2] = ATT_MFMA(vA[kk], pf[kk], o[2]);
#pragma unroll
            for (int i = 0; i < 8; ++i) s1[i] = __builtin_amdgcn_exp2f(s1[i]);
#pragma unroll
            for (int i = 0; i < 8; ++i) l2 += (f32x2){s0[2 * i], s0[2 * i + 1]};
            DF_SB();
#pragma unroll
            for (int kk = 0; kk < 4; ++kk) o[3] = ATT_MFMA(vB[kk], pf[kk], o[3]);
#pragma unroll
            for (int i = 8; i < 16; ++i) s1[i] = __builtin_amdgcn_exp2f(s1[i]);
            DF_SB();
#pragma unroll
            for (int i = 0; i < 8; ++i) l2 += (f32x2){s1[2 * i], s1[2 * i + 1]};
            pf[0] = pack_frag(s0, 0); pf[1] = pack_frag(s0, 8); pf[2] = pack_frag(s1, 0); pf[3] = pack_frag(s1, 8);
        }
        asm volatile("s_waitcnt vmcnt(0)" ::: "memory"); __builtin_amdgcn_s_barrier(); asm volatile("" ::: "memory");
        { const ldsp vb_ = lds + RV + ((n - 1) & 3) * RS + vreadr;
#pragma unroll
          for (int eb = 0; eb < 4; ++eb)
#pragma unroll
              for (int kk = 0; kk < 4; ++kk) { const s16x4 lo_ = vtr(vb_ + eb * 4096 + kk * 1024), hi_ = vtr(vb_ + eb * 4096 + kk * 1024 + 512);
                  o[eb] = ATT_MFMA(__builtin_shufflevector(lo_, hi_, 0, 1, 2, 3, 4, 5, 6, 7), pf[kk], o[eb]); } }
        l = l2.x + l2.y;
        __syncthreads();
#undef DF_DMA
#undef DF_DMAK
#undef DF_DMAV
#undef DF_CF
#undef DF_INIT
#undef DF_VLOAD
#undef DF_SB
#undef DF_CL
    } else {
    u32x4 sk0, sk1, sv0, sv1;
    const int kl0 = kl0r, kl1 = kl1r, vl0 = DKBUF + vl0r, vl1 = DKBUF + vl1r, vread = DKBUF + vreadr;
    float m = -1e30f;
    { const size_t go = (size_t)tlo * 64 * 1024;
      sk0 = *(const u32x4*)(kg + go); sk1 = *(const u32x4*)(kg + go + 32 * 1024); sv0 = *(const u32x4*)(vg + go); sv1 = *(const u32x4*)(vg + go + 32 * 1024); }
    *(ATT_LAS u32x4*)(lds + kl0) = sk0; *(ATT_LAS u32x4*)(lds + kl1) = sk1; *(ATT_LAS u32x4*)(lds + vl0) = sv0; *(ATT_LAS u32x4*)(lds + vl1) = sv1;
    __syncthreads();
    for (int t = tlo; t <= thi; ++t) {
        const int bsel = (t - tlo) & 1;
        const ldsp cur = lds + bsel * DBUF;
        const bool more = (t < thi);
        if (more) { const size_t go = (size_t)(t + 1) * 64 * 1024;
            sk0 = *(const u32x4*)(kg + go); sk1 = *(const u32x4*)(kg + go + 32 * 1024); sv0 = *(const u32x4*)(vg + go); sv1 = *(const u32x4*)(vg + go + 32 * 1024); }
        f32x16 s0, s1;
#pragma unroll
        for (int i = 0; i < 16; ++i) { s0[i] = 0.f; s1[i] = 0.f; }
#pragma unroll
        for (int ks = 0; ks < 4; ++ks) {
            const bf16x8 k0 = *(const ATT_LAS bf16x8*)(cur + kread + ks * 32);
            const bf16x8 k1 = *(const ATT_LAS bf16x8*)(cur + kread + 32 * DKP + ks * 32);
            s0 = ATT_MFMA(k0, qf[ks], s0); s1 = ATT_MFMA(k1, qf[ks], s1);
        }
        const float dbase = (float)(t * 64 + 4 * hh - qpos);
        float mx = -1e30f;
#pragma unroll
        for (int i = 0; i < 16; ++i) { const float d0 = dbase + (float)((i & 3) + 8 * (i >> 2));
            s0[i] = __builtin_fmaf(nslope2, __builtin_fabsf(d0), s0[i]); s1[i] = __builtin_fmaf(nslope2, __builtin_fabsf(d0 + 32.f), s1[i]);
            mx = fmaxf(mx, fmaxf(s0[i], s1[i])); }
        mx = fmaxf(mx, __shfl_xor(mx, 32));
        if (__any(mx > m)) { const float mn = fmaxf(m, mx), al = __builtin_amdgcn_exp2f(m - mn); m = mn; l *= al;
#pragma unroll
            for (int eb = 0; eb < 4; ++eb) o[eb] *= al; }
        float rs = 0.f;
#pragma unroll
        for (int i = 0; i < 16; ++i) { s0[i] = __builtin_amdgcn_exp2f(s0[i] - m); s1[i] = __builtin_amdgcn_exp2f(s1[i] - m); rs += s0[i] + s1[i]; }
        l += rs;
        bf16x8 pf[4]; pf[0] = pack_frag(s0, 0); pf[1] = pack_frag(s0, 8); pf[2] = pack_frag(s1, 0); pf[3] = pack_frag(s1, 8);
#pragma unroll
        for (int eb = 0; eb < 4; ++eb)
#pragma unroll
            for (int kk = 0; kk < 4; ++kk) {
                const s16x4 lo = vtr(cur + vread + eb * 4096 + kk * 1024), hi = vtr(cur + vread + eb * 4096 + kk * 1024 + 512);
                const bf16x8 vf = __builtin_shufflevector(lo, hi, 0, 1, 2, 3, 4, 5, 6, 7);
                o[eb] = ATT_MFMA(vf, pf[kk], o[eb]);
            }
        if (more) { const ldsp nx = lds + (bsel ^ 1) * DBUF;
            *(ATT_LAS u32x4*)(nx + kl0) = sk0; *(ATT_LAS u32x4*)(nx + kl1) = sk1; *(ATT_LAS u32x4*)(nx + vl0) = sv0; *(ATT_LAS u32x4*)(nx + vl1) = sv1; }
        __syncthreads();
    }
    }
    l += __shfl_xor(l, 32);
    const float inv = 1.f / l;
    ATT_LAS float* X = (ATT_LAS float*)(lds + DXOFF) + qsub * 4096 + lane;
    if (c == 1) {
#pragma unroll
        for (int eb = 0; eb < 4; ++eb)
#pragma unroll
            for (int i = 0; i < 16; ++i) X[(eb * 16 + i) * 64] = o[eb][i] * inv;
    }
    __syncthreads();
    if (c == 0) {
        float ss = 0.f;
#pragma unroll
        for (int eb = 0; eb < 4; ++eb)
#pragma unroll
            for (int i = 0; i < 16; ++i) { const float v = o[eb][i] * inv - lam * X[(eb * 16 + i) * 64]; o[eb][i] = v; ss += v * v; }
        ss += __shfl_xor(ss, 32);
        const float rn = 0.8f * __builtin_amdgcn_rsqf(ss * (1.f / 128.f) + LN_EPS);
        bf16_t* orow = Op + (size_t)(rowbase + qpos) * 1024 + h * 128 + 4 * hh;
#pragma unroll
        for (int eb = 0; eb < 4; ++eb)
#pragma unroll
            for (int g4 = 0; g4 < 4; ++g4) { const int e0 = eb * 32 + 8 * g4;
                const float4 gv = *(const float4*)(subln_g + e0 + 4 * hh);
                u32x2 w; w.x = pg8::pk_bf16(o[eb][4 * g4] * rn * gv.x, o[eb][4 * g4 + 1] * rn * gv.y); w.y = pg8::pk_bf16(o[eb][4 * g4 + 2] * rn * gv.z, o[eb][4 * g4 + 3] * rn * gv.w);
                *(u32x2*)(orow + e0) = w; }
    }
    __syncthreads();
}

constexpr int WKP = 144;
constexpr int WKBUF = 64 * WKP, WVBUF = 64 * 128, WBUF = WKBUF + WVBUF;

__device__ __forceinline__ void win_unit(ldsp lds, const bf16_t* Qp, const bf16_t* Kp, const bf16_t* Vp, bf16_t* Op,
                                         long rowbase, int S, int hq, int qblk, const float* __restrict__ sink) {
    int tid_ = threadIdx.x; asm volatile("" : "+v"(tid_));
    const int tid = tid_, lane = tid & 63, r = lane & 31, hh = lane >> 5;
    const int wid = __builtin_amdgcn_readfirstlane(tid >> 6), g = hq >> 2;
    const int q0 = qblk * 256, qw0 = q0 + wid * 32, qpos = qw0 + r;
    const float nslope2 = -LOG2E * __builtin_amdgcn_exp2f(-0.5f * (float)(hq + 1));
    bf16x8 qf[4];
    { const bf16_t* qptr = Qp + (size_t)(rowbase + qpos) * 1024 + hq * 64 + hh * 8;
#pragma unroll
      for (int ks = 0; ks < 4; ++ks) qf[ks] = *(const bf16x8*)(qptr + ks * 16); }
    const int skey = tid >> 3, sch = tid & 7;
    const bf16_t* kg = Kp + (size_t)(rowbase + skey) * 256 + g * 64 + sch * 8;
    const bf16_t* vg = Vp + (size_t)(rowbase + skey) * 256 + g * 64 + sch * 8;
    const int kl = skey * WKP + sch * 16, vl = WKBUF + voff(skey, sch);
    const int NT = S / 64;
    int tlo = q0 / 64 - 2; if (tlo < 0) tlo = 0;
    int thi = q0 / 64 + 5; if (thi > NT - 1) thi = NT - 1;
    u32x4 sk, sv;
    sk = *(const u32x4*)(kg + (size_t)tlo * 64 * 256); sv = *(const u32x4*)(vg + (size_t)tlo * 64 * 256);
    *(ATT_LAS u32x4*)(lds + kl) = sk; *(ATT_LAS u32x4*)(lds + vl) = sv;
    __syncthreads();
    float m = -1e30f, l = 0.f;
    f32x16 o[2];
#pragma unroll
    for (int eb = 0; eb < 2; ++eb)
#pragma unroll
        for (int i = 0; i < 16; ++i) o[eb][i] = 0.f;
    const int kread = r * WKP + hh * 16;
    const int vread = WKBUF + (4 * hh + ((lane & 15) >> 2)) * 64 + ((lane >> 4) & 1) * 32 + (lane & 3) * 8;
    for (int t = tlo; t <= thi; ++t) {
        const int b = (t - tlo) & 1;
        const ldsp cur = lds + b * WBUF;
        const bool more = (t < thi);
        if (more) { const size_t go = (size_t)(t + 1) * 64 * 256; sk = *(const u32x4*)(kg + go); sv = *(const u32x4*)(vg + go); }
        const bool active = (t * 64 + 63 >= qw0 - 128) && (t * 64 <= qw0 + 31 + 128);
        if (active) {
            f32x16 s0, s1;
#pragma unroll
            for (int i = 0; i < 16; ++i) { s0[i] = 0.f; s1[i] = 0.f; }
#pragma unroll
            for (int ks = 0; ks < 4; ++ks) {
                const bf16x8 k0 = *(const ATT_LAS bf16x8*)(cur + kread + ks * 32);
                const bf16x8 k1 = *(const ATT_LAS bf16x8*)(cur + kread + 32 * WKP + ks * 32);
                s0 = ATT_MFMA(k0, qf[ks], s0); s1 = ATT_MFMA(k1, qf[ks], s1);
            }
            const float dbase = (float)(t * 64 + 4 * hh - qpos);
            float mx = -INFINITY;
#pragma unroll
            for (int i = 0; i < 16; ++i) { const float d0 = __builtin_fabsf(dbase + (float)((i & 3) + 8 * (i >> 2))), d1 = __builtin_fabsf(dbase + (float)(32 + (i & 3) + 8 * (i >> 2)));
                s0[i] = d0 <= 128.f ? __builtin_fmaf(nslope2, d0, s0[i]) : -INFINITY; s1[i] = d1 <= 128.f ? __builtin_fmaf(nslope2, d1, s1[i]) : -INFINITY;
                mx = fmaxf(mx, fmaxf(s0[i], s1[i])); }
            mx = fmaxf(mx, __shfl_xor(mx, 32));
            if (__any(mx > m)) { const float mn = fmaxf(m, mx), al = __builtin_amdgcn_exp2f(m - mn); m = mn; l *= al;
#pragma unroll
                for (int eb = 0; eb < 2; ++eb) o[eb] *= al; }
            float rs = 0.f;
#pragma unroll
            for (int i = 0; i < 16; ++i) { s0[i] = __builtin_amdgcn_exp2f(s0[i] - m); s1[i] = __builtin_amdgcn_exp2f(s1[i] - m); rs += s0[i] + s1[i]; }
            l += rs;
            bf16x8 pf[4]; pf[0] = pack_frag(s0, 0); pf[1] = pack_frag(s0, 8); pf[2] = pack_frag(s1, 0); pf[3] = pack_frag(s1, 8);
#pragma unroll
            for (int eb = 0; eb < 2; ++eb)
#pragma unroll
                for (int kk = 0; kk < 4; ++kk) {
                    const s16x4 lo = vtr(cur + vread + eb * 4096 + kk * 1024), hi = vtr(cur + vread + eb * 4096 + kk * 1024 + 512);
                    const bf16x8 vf = __builtin_shufflevector(lo, hi, 0, 1, 2, 3, 4, 5, 6, 7);
                    o[eb] = ATT_MFMA(vf, pf[kk], o[eb]);
                }
        }
        if (more) { const ldsp nx = lds + (b ^ 1) * WBUF; *(ATT_LAS u32x4*)(nx + kl) = sk; *(ATT_LAS u32x4*)(nx + vl) = sv; }
        __syncthreads();
    }
    l += __shfl_xor(l, 32);
    const float sk2 = sink[hq] * LOG2E, mf = fmaxf(m, sk2), sc = __builtin_amdgcn_exp2f(m - mf);
    const float inv = sc / (l * sc + __builtin_amdgcn_exp2f(sk2 - mf));
    bf16_t* orow = Op + (size_t)(rowbase + qpos) * 1024 + hq * 64 + 4 * hh;
#pragma unroll
    for (int eb = 0; eb < 2; ++eb)
#pragma unroll
        for (int g4 = 0; g4 < 4; ++g4) { const int e0 = eb * 32 + 8 * g4;
            u32x2 w; w.x = pg8::pk_bf16(o[eb][4 * g4] * inv, o[eb][4 * g4 + 1] * inv); w.y = pg8::pk_bf16(o[eb][4 * g4 + 2] * inv, o[eb][4 * g4 + 3] * inv);
            *(u32x2*)(orow + e0) = w; }
}
}

#define LAS __attribute__((address_space(3)))
typedef unsigned short bf16;
typedef unsigned v4u __attribute__((ext_vector_type(4)));
typedef float f32x4 __attribute__((ext_vector_type(4)));
constexpr int NWAVES = 8;
constexpr int T_P = 8 * 8192, T_S = 2 * 16384, T_ALL = T_P + T_S;
constexpr int DM = 1024, DFF = 4096, IN_COLS = 6656, QKV_COLS = 4608, GATE_COLS = 2048;
constexpr float DN_ALPHA = 1.189207115002721f;
constexpr float LN_EPS = 1e-5f;
constexpr int LDS_BYTES = 147456;
static_assert(att::D_LDS <= LDS_BYTES && pg8::STAGE_BYTES <= LDS_BYTES, "LDS map");
constexpr size_t WS_WIN = 0;
constexpr size_t WS_WBRA = WS_WIN + (size_t)IN_COLS * DM * 2;
constexpr size_t WS_WBRB = WS_WBRA + (size_t)DM * DM * 2;
constexpr size_t WS_WOUT = WS_WBRB + (size_t)DM * DM * 2;
constexpr size_t WS_WFF1 = WS_WOUT + (size_t)DM * DM * 2;
constexpr size_t WS_WFF2 = WS_WFF1 + (size_t)DFF * DM * 2;
constexpr size_t WS_BIG = WS_WFF2 + (size_t)DFF * DM * 2;
constexpr size_t PLANE = (size_t)T_ALL * DM * 2;
constexpr size_t WS_PA = WS_BIG, WS_PB = WS_PA + PLANE, WS_PC = WS_PB + PLANE, WS_PD = WS_PC + PLANE;
constexpr size_t WS_TAIL = WS_PD + PLANE;
constexpr size_t WS_PE = WS_TAIL, WS_PF = WS_PE + (size_t)T_ALL * 256 * 2;
constexpr size_t WS_CTL = WS_TAIL + PLANE;
constexpr size_t WS_END = WS_CTL + 8192;
constexpr int LDS_CTL = 135168;
static_assert(att::D_LDS <= LDS_CTL && LDS_CTL + 16 <= 147456, "LDS ctl word");

__device__ __forceinline__ unsigned f2bf(float f) { unsigned u = __builtin_bit_cast(unsigned, f); return (u + 0x7fffu + ((u >> 16) & 1u)) >> 16; }
__device__ __forceinline__ unsigned pk2(float lo, float hi) { return f2bf(lo) | (f2bf(hi) << 16); }
__device__ __forceinline__ float wave_sum(float v) {
#pragma unroll
    for (int o = 1; o < 64; o <<= 1) v += __shfl_xor(v, o);
    return v;
}
__device__ __forceinline__ void p0_transpose_item(const float* W, int K, int N, bf16* WT, LAS float* scr, int item, int lane) {
    const int nblk = N / 32, kb = item / nblk, nb = item % nblk, k0 = 64 * kb, n0 = 32 * nb;
#pragma unroll 8
    for (int i = 0; i < 32; ++i) { const int kk = 2 * i + (lane >> 5); scr[kk * 33 + (lane & 31)] = W[(size_t)(k0 + kk) * N + n0 + (lane & 31)]; }
    asm volatile("s_waitcnt lgkmcnt(0)" ::: "memory");
    const int c = lane & 7;
#pragma unroll
    for (int j = 0; j < 4; ++j) { const int n = (lane >> 3) + 8 * j; const LAS float* s = scr + (8 * c) * 33 + n;
        v4u o; o.x = pk2(s[0 * 33], s[1 * 33]); o.y = pk2(s[2 * 33], s[3 * 33]); o.z = pk2(s[4 * 33], s[5 * 33]); o.w = pk2(s[6 * 33], s[7 * 33]);
        *(v4u*)(WT + (size_t)(n0 + n) * K + k0 + 8 * c) = o; }
    asm volatile("s_waitcnt lgkmcnt(0)" ::: "memory");
}
template <bool WITH_BF16> __device__ __forceinline__ void ln_rows(float* Z, bf16* Zb, const float* __restrict__ gam, const float* __restrict__ bet, int gw, int NGW, int lane) {
    f32x4 gv[4], bv[4];
#pragma unroll
    for (int j = 0; j < 4; ++j) { gv[j] = *((const f32x4*)gam + 64 * j + lane); bv[j] = *((const f32x4*)bet + 64 * j + lane); }
    for (int m = gw; m < T_ALL; m += NGW) {
        f32x4* zr = (f32x4*)(Z + (size_t)m * DM) + lane;
        f32x4 v[4]; float s = 0.f;
#pragma unroll
        for (int j = 0; j < 4; ++j) { v[j] = zr[64 * j]; s += (v[j].x + v[j].y) + (v[j].z + v[j].w); }
        const float mean = wave_sum(s) * (1.f / DM); float s2 = 0.f;
#pragma unroll
        for (int j = 0; j < 4; ++j) { v[j] = v[j] - mean; s2 += (v[j].x * v[j].x + v[j].y * v[j].y) + (v[j].z * v[j].z + v[j].w * v[j].w); }
        const float rstd = 1.f / sqrtf(wave_sum(s2) * (1.f / DM) + LN_EPS);
#pragma unroll
        for (int j = 0; j < 4; ++j) { const f32x4 y = v[j] * rstd * gv[j] + bv[j]; zr[64 * j] = y;
            if (WITH_BF16) { unsigned long long* o8 = (unsigned long long*)(Zb + (size_t)m * DM) + lane;
                o8[64 * j] = (unsigned long long)pk2(y.x, y.y) | ((unsigned long long)pk2(y.z, y.w) << 32); } }
    }
}

struct Args { const float* in[21]; float* out; unsigned char* ws; };

__global__ void __launch_bounds__(NWAVES * 64) fwd_megakernel(Args a) {
    extern __shared__ __attribute__((aligned(16))) unsigned char lds_raw[];
    cg::grid_group grid = cg::this_grid();
    LAS unsigned char* lds = (LAS unsigned char*)lds_raw;
    const int tid = threadIdx.x, lane = tid & 63, wave = __builtin_amdgcn_readfirstlane(tid >> 6);
    const int G = gridDim.x, bx = blockIdx.x;
    const int vcu = (G % 8 == 0) ? (bx % 8) * (G / 8) + bx / 8 : bx;
    const int gw = vcu * NWAVES + wave, NGW = G * NWAVES;
    unsigned char* ws = a.ws;
    bf16* WinT = (bf16*)(ws + WS_WIN); bf16* WbraT = (bf16*)(ws + WS_WBRA); bf16* WbrbT = (bf16*)(ws + WS_WBRB); bf16* WoutT = (bf16*)(ws + WS_WOUT);
    bf16* Wff1T = (bf16*)(ws + WS_WFF1); bf16* Wff2T = (bf16*)(ws + WS_WFF2);
    bf16* PA = (bf16*)(ws + WS_PA); bf16* PB = (bf16*)(ws + WS_PB); bf16* PC = (bf16*)(ws + WS_PC); bf16* PD = (bf16*)(ws + WS_PD);
    bf16* PE = (bf16*)(ws + WS_PE); bf16* PF = (bf16*)(ws + WS_PF);
    bf16* GM = PB;
    bf16* HB = PA;
    bf16* X1B = (bf16*)(ws + WS_TAIL);
    bf16* XB = (bf16*)a.out;
    float* OUT = a.out;

    unsigned* ctl = (unsigned*)(ws + WS_CTL);
    {
        if (bx == 0) for (int i = tid; i < 2048; i += NWAVES * 64) ctl[i] = 0u;
        LAS float* scr = (LAS float*)(lds + wave * 16384);
        constexpr int I_IN = (DM / 64) * (IN_COLS / 32), I_SQ = (DM / 64) * (DM / 32), I_F1 = (DM / 64) * (DFF / 32), I_F2 = (DFF / 64) * (DM / 32);
        constexpr int NITEMS = I_IN + 3 * I_SQ + I_F1 + I_F2;
        for (int it = gw; it < NITEMS; it += NGW) {
            int r = it;
            if (r < I_IN) { p0_transpose_item(a.in[2], DM, IN_COLS, WinT, scr, r, lane); continue; } r -= I_IN;
            if (r < I_SQ) { p0_transpose_item(a.in[10], DM, DM, WbraT, scr, r, lane); continue; } r -= I_SQ;
            if (r < I_SQ) { p0_transpose_item(a.in[11], DM, DM, WbrbT, scr, r, lane); continue; } r -= I_SQ;
            if (r < I_SQ) { p0_transpose_item(a.in[12], DM, DM, WoutT, scr, r, lane); continue; } r -= I_SQ;
            if (r < I_F1) { p0_transpose_item(a.in[15], DM, DFF, Wff1T, scr, r, lane); continue; } r -= I_F1;
            p0_transpose_item(a.in[17], DFF, DM, Wff2T, scr, r, lane);
        }
        const size_t n8 = (size_t)T_ALL * DM / 8, np8 = (size_t)T_P * DM / 8;
        for (size_t i = (size_t)vcu * (NWAVES * 64) + tid; i < n8; i += (size_t)G * (NWAVES * 64)) {
            const float* src = i < np8 ? a.in[0] + i * 8 : a.in[1] + (i - np8) * 8;
            const f32x4 v0 = *(const f32x4*)src, v1 = *(const f32x4*)(src + 4);
            v4u o; o.x = pk2(v0.x, v0.y); o.y = pk2(v0.z, v0.w); o.z = pk2(v1.x, v1.y); o.w = pk2(v1.z, v1.w);
            *(v4u*)(XB + i * 8) = o;
        }
    }
    grid.sync();

    {
        pg8::Gemm g{XB, WinT, T_ALL, QKV_COLS, DM, DM, DM}; pg8::StaticOrder S; S.init(T_ALL, QKV_COLS, G, bx);
        pg8::EpiQKV E{PA, PB, PC, PD, PE, PF, att::QSCALE, ctl};
        pg8::gemm_phase<pg8::EpiQKV, pg8::StaticOrder, true, true>(lds, g, S, E);
    }
    grid.sync();

    {
        float s1 = 0.f, s2 = 0.f;
        for (int i = 0; i < 64; ++i) { s1 += a.in[4][i] * a.in[5][i]; s2 += a.in[6][i] * a.in[7][i]; }
        const float lam = __expf(s1) - __expf(s2) + 0.2f;
        volatile LAS int* bcast = (volatile LAS int*)(lds + LDS_CTL);
        for (int qi = 0; qi < 8; ++qi) {
            const int x = (bx + qi) & 7;
            for (;;) {
                if (tid == 0) bcast[0] = (int)atomicAdd(ctl + 1024 + 64 * x, 1u);
                __syncthreads();
                const int i = __builtin_amdgcn_readfirstlane(bcast[0]);
                __syncthreads();
                if (i >= 768) break;
                const int si = i >> 5, w = i & 31, gi = si / 3, j = si - 3 * gi, h = 7 - gi, cs = (x + h) & 7;
                if (j == 0) { const int b = cs >> 2, part = cs & 3;
                    att::diff_unit(lds, PA, PB, PC, PA, (long)T_P + (long)b * 16384, 16384, h, part * 32 + w, lam, a.in[8], ctl + (8 + b) * 64); }
                else { const int cp = cs + 8 * (j - 1), b = cp >> 1, part = cp & 1;
                    att::diff_unit(lds, PA, PB, PC, PA, (long)b * 8192, 8192, h, part * 32 + w, lam, a.in[8], ctl + b * 64); }
            }
        }
        for (int it = vcu; it < 6144; it += G) {
            if (it < 4096) { const int b = it / (16 * 32), hq = (it / 32) % 16, qb = it % 32;
                att::win_unit(lds, PD, PE, PF, PD, (long)b * 8192, 8192, hq, qb, a.in[9]); }
            else { const int i2 = it - 4096; const int b = i2 / (16 * 64), hq = (i2 / 64) % 16, qb = i2 % 64;
                att::win_unit(lds, PD, PE, PF, PD, (long)T_P + (long)b * 16384, 16384, hq, qb, a.in[9]); }
        }
    }
    grid.sync();

    {
        pg8::Gemm g{XB, WinT + (size_t)QKV_COLS * DM, T_ALL, GATE_COLS, DM, DM, DM}; pg8::StaticOrder S; S.init(T_ALL, GATE_COLS, G, bx);
        pg8::EpiGate E{GM, a.in[3]};
        pg8::gemm_phase<pg8::EpiGate, pg8::StaticOrder, true, true>(lds, g, S, E);
    }
    grid.sync();

    {
        pg8::Gemm g{PA, WbraT, T_ALL, DM, DM, DM, DM}; pg8::StaticOrder S; S.init(T_ALL, DM, G, bx);
        pg8::EpiBranch<false> E{GM};
        pg8::gemm_phase<pg8::EpiBranch<false>, pg8::StaticOrder, true, true>(lds, g, S, E);
    }
    __syncthreads();
    {
        pg8::Gemm g{PD, WbrbT, T_ALL, DM, DM, DM, DM}; pg8::StaticOrder S; S.init(T_ALL, DM, G, bx);
        pg8::EpiBranch<true> E{GM};
        pg8::gemm_phase<pg8::EpiBranch<true>, pg8::StaticOrder, true, true>(lds, g, S, E);
    }
    grid.sync();

    {
        pg8::Gemm g{GM, WoutT, T_ALL, DM, DM, 2048, DM}; pg8::StaticOrder S; S.init(T_ALL, DM, G, bx);
        pg8::EpiRes E{a.in[0], a.in[1], T_P, OUT, nullptr, DN_ALPHA};
        pg8::gemm_phase<pg8::EpiRes, pg8::StaticOrder, true, true>(lds, g, S, E);
    }
    grid.sync();

    ln_rows<true>(OUT, X1B, a.in[13], a.in[14], gw, NGW, lane);
    grid.sync();

    {
        pg8::Gemm g{X1B, Wff1T, T_ALL, DFF, DM, DM, DM}; pg8::StaticOrder S; S.init(T_ALL, DFF, G, bx);
        pg8::EpiFF1 E{HB, a.in[16]};
        pg8::gemm_phase<pg8::EpiFF1, pg8::StaticOrder, true, true>(lds, g, S, E);
    }
    grid.sync();

    {
        pg8::Gemm g{HB, Wff2T, T_ALL, DM, DFF, DFF, DFF}; pg8::StaticOrder S; S.init(T_ALL, DM, G, bx);
        pg8::EpiRes E{OUT, OUT, 1 << 30, OUT, a.in[18], DN_ALPHA};
        pg8::gemm_phase<pg8::EpiRes, pg8::StaticOrder, true, true>(lds, g, S, E);
    }
    grid.sync();

    ln_rows<false>(OUT, nullptr, a.in[19], a.in[20], gw, NGW, lane);
}

extern "C" void kernel_launch(void* const* d_in, const int* in_sizes, int n_in, void* d_out, int out_size, void* d_ws, size_t ws_size, hipStream_t stream) {
    static int grid = 0;
    if (grid == 0) {
        if (n_in != 21 || out_size != T_ALL * DM || ws_size < WS_END) { fprintf(stderr, "kernel_launch: unexpected shapes (n_in %d, out %d, ws %zu < %zu)\n", n_in, out_size, ws_size, (size_t)WS_END); grid = -1; return; }
        int dev = 0, cus = 0, per_cu = 0;
        (void)hipGetDevice(&dev);
        (void)hipDeviceGetAttribute(&cus, hipDeviceAttributeMultiprocessorCount, dev);
        (void)hipFuncSetAttribute((const void*)fwd_megakernel, hipFuncAttributeMaxDynamicSharedMemorySize, LDS_BYTES);
        if (hipOccupancyMaxActiveBlocksPerMultiprocessor(&per_cu, (const void*)fwd_megakernel, NWAVES * 64, LDS_BYTES) != hipSuccess || per_cu < 1) per_cu = 1;
        (void)hipGetLastError();
        if (cus <= 0) cus = 256;
        grid = cus * per_cu;
    }
    if (grid < 0) return;
    Args a{};
    for (int i = 0; i < 21; ++i) a.in[i] = (const float*)d_in[i];
    a.out = (float*)d_out; a.ws = (unsigned char*)d_ws;
    void* args[] = {&a};
    hipError_t e = hipLaunchCooperativeKernel((const void*)fwd_megakernel, dim3(grid), dim3(NWAVES * 64), args, LDS_BYTES, stream);
    if (e != hipSuccess) fprintf(stderr, "cooperative launch failed: %s (grid %d)\n", hipGetErrorString(e), grid);
}
```

```cpp
#include <hip/hip_runtime.h>
#include <hip/hip_cooperative_groups.h>
#include <cstdio>
#include <cstdint>
namespace cg = cooperative_groups;

namespace pg8 {
#define PG8_LAS __attribute__((address_space(3)))
typedef unsigned short bf16_t;
typedef short bf16x8 __attribute__((ext_vector_type(8)));
typedef float f32x4 __attribute__((ext_vector_type(4)));
typedef unsigned u32x4 __attribute__((ext_vector_type(4)));
constexpr int BM = 256, BK = 64, HALF = 128, HTB = HALF * BK * 2  , STAGE_BYTES = 8 * HTB, NXCD = 8, WGM = 8;

__host__ __device__ __forceinline__ int lds_byte(int r, int c) { const int st = (r >> 4) * 2 + (c >> 5), rr = r & 15, cc = c & 31, ob = rr * 64 + cc * 2; return st * 1024 + (ob ^ (((ob >> 9) & 1) << 5)); }
__host__ __device__ __forceinline__ void stage_rc(int b, int& R, int& C) { const int st = b / 1024, sb = b % 1024, swz = sb ^ (((sb >> 9) & 1) << 5); R = (st >> 1) * 16 + swz / 64; C = (st & 1) * 32 + (swz % 64) / 2; }
__host__ __device__ __forceinline__ int perm32(int rho) { const int n = rho >> 4, i = rho & 15; return 8 * (i >> 2) + 4 * n + (i & 3); }

struct Unit { int pm, pn; };
struct Gemm { const bf16_t* A; const bf16_t* Bt; int M, N, K, lda, ldb; };

struct StaticOrder {
    int nM, nN, nwg, G, c;
    __host__ __device__ void init(int M, int N, int G_, int c_) { nM = M / BM; nN = N / BM; nwg = nM * nN; G = G_; c = c_; }
    __host__ __device__ bool next(int i, Unit& u) const {
        const long L = (long)i * G + c; if (L >= nwg) return false;
        int wgid = (int)L; { const int q = nwg / NXCD, r = nwg % NXCD, xcd = wgid % NXCD, off = wgid / NXCD; wgid = (xcd < r ? xcd * (q + 1) : r * (q + 1) + (xcd - r) * q) + off; }
        const int nig = WGM * nN, gid = wgid / nig, fm = gid * WGM, gsz = (nM - fm) < WGM ? (nM - fm) : WGM;
        u.pm = fm + ((wgid % nig) % gsz); u.pn = (wgid % nig) / gsz; return true;
    }
    __device__ __forceinline__ void a_ready(const Unit&) const {}
    __device__ __forceinline__ void done(const Unit&) const {}
};

typedef __bf16 bf16x2_t __attribute__((ext_vector_type(2)));
typedef float f32x2_t __attribute__((ext_vector_type(2)));
__device__ __forceinline__ unsigned pk_bf16(float lo, float hi) { f32x2_t v = {lo, hi}; bf16x2_t b = __builtin_convertvector(v, bf16x2_t); return __builtin_bit_cast(unsigned, b); }
__device__ __forceinline__ float bf_lo(unsigned w) { return __uint_as_float(w << 16); }
__device__ __forceinline__ float bf_hi(unsigned w) { return __uint_as_float(w & 0xffff0000u); }
__device__ __forceinline__ u32x4 pack8(const f32x4 a, const f32x4 b) { u32x4 w; w.x = pk_bf16(a[0], a[1]); w.y = pk_bf16(a[2], a[3]); w.z = pk_bf16(b[0], b[1]); w.w = pk_bf16(b[2], b[3]); return w; }
#define PG8_ROWFENCE() asm volatile("" ::: "memory")

struct EpiQKV {
    static constexpr bool PERM = true, AFTER_DRAIN = false;
    bf16_t *PA, *PB, *PC, *PD, *PE, *PF; float qscale; unsigned* stats;
    __device__ __forceinline__ void operator()(const f32x4 (&acc)[2][2][4][2], const Unit& u, int wr, int wc, int fr, int fq) const {
        const int pn = u.pn; bf16_t* base; int ld = 1024, cb; float sc = 1.f;
        if (pn < 8) {
            const float s0 = pn < 4 ? qscale : 1.f; float rmax[2] = {0.f, 0.f};
#pragma unroll
            for (int ai = 0; ai < 2; ++ai)
#pragma unroll
                for (int m = 0; m < 4; ++m)
#pragma unroll
                    for (int bj = 0; bj < 2; ++bj) { const f32x4 a = acc[ai][bj][m][0] * s0, b = acc[ai][bj][m][1] * s0;
                        float q = (a[0] * a[0] + a[1] * a[1]) + (a[2] * a[2] + a[3] * a[3]) + (b[0] * b[0] + b[1] * b[1]) + (b[2] * b[2] + b[3] * b[3]);
                        q += __shfl_xor(q, 16); q += __shfl_xor(q, 32); rmax[bj] = fmaxf(rmax[bj], q); }
#pragma unroll
            for (int bj = 0; bj < 2; ++bj) { float q = rmax[bj];
                q = fmaxf(q, __shfl_xor(q, 1)); q = fmaxf(q, __shfl_xor(q, 2)); q = fmaxf(q, __shfl_xor(q, 4)); q = fmaxf(q, __shfl_xor(q, 8));
                const int rowt = u.pm * BM, seq = rowt < 65536 ? (rowt >> 13) : 8 + ((rowt - 65536) >> 14);
                if (fr == 0 && fq == 0) atomicMax(stats + (seq * 2 + (pn >> 2)) * 32 + (pn & 3) * 8 + bj * 4 + wc, __float_as_uint(q)); }
        }
        if (pn < 4) { base = PA; cb = pn * 256; sc = qscale; }
        else if (pn < 8) { base = PB; cb = (pn - 4) * 256; }
        else if (pn < 12) { base = PC; cb = (pn - 8) * 256; }
        else if (pn < 16) { base = PD; cb = (pn - 12) * 256; sc = qscale; }
        else if (pn == 16) { base = PE; ld = 256; cb = 0; }
        else { base = PF; ld = 256; cb = 0; }
        const int row0 = u.pm * BM + wr * 64 + fr, col0 = cb + wc * 32 + 8 * fq;
#pragma unroll
        for (int ai = 0; ai < 2; ++ai)
#pragma unroll
            for (int m = 0; m < 4; ++m) { bf16_t* rowp = base + (size_t)(row0 + ai * HALF + m * 16) * ld + col0;
#pragma unroll
                for (int bj = 0; bj < 2; ++bj) *(u32x4*)(rowp + bj * HALF) = pack8(acc[ai][bj][m][0] * sc, acc[ai][bj][m][1] * sc); }
    }
};
struct EpiGate {
    static constexpr bool PERM = true, AFTER_DRAIN = false;
    bf16_t* G; const float* bias;
    __device__ __forceinline__ void operator()(const f32x4 (&acc)[2][2][4][2], const Unit& u, int wr, int wc, int fr, int fq) const {
        const int row0 = u.pm * BM + wr * 64 + fr, col0 = u.pn * BM + wc * 32 + 8 * fq;
        f32x4 bv[2][2];
#pragma unroll
        for (int bj = 0; bj < 2; ++bj)
#pragma unroll
            for (int n = 0; n < 2; ++n) bv[bj][n] = *(const f32x4*)(bias + col0 + bj * HALF + 4 * n);
#pragma unroll
        for (int ai = 0; ai < 2; ++ai)
#pragma unroll
            for (int m = 0; m < 4; ++m) { bf16_t* rowp = G + (size_t)(row0 + ai * HALF + m * 16) * 2048 + col0;
#pragma unroll
                for (int bj = 0; bj < 2; ++bj) { f32x4 v0 = acc[ai][bj][m][0] + bv[bj][0], v1 = acc[ai][bj][m][1] + bv[bj][1];
#pragma unroll
                    for (int e = 0; e < 4; ++e) { v0[e] = __builtin_amdgcn_rcpf(1.f + __expf(-v0[e])); v1[e] = __builtin_amdgcn_rcpf(1.f + __expf(-v1[e])); }
                    *(u32x4*)(rowp + bj * HALF) = pack8(v0, v1); } }
    }
};
template <bool SECOND> struct EpiBranch {
    static constexpr bool PERM = true, AFTER_DRAIN = false;
    bf16_t* G;
    __device__ __forceinline__ void operator()(const f32x4 (&acc)[2][2][4][2], const Unit& u, int wr, int wc, int fr, int fq) const {
        const int row0 = u.pm * BM + wr * 64 + fr, col0 = u.pn * BM + wc * 32 + 8 * fq;
#pragma unroll
        for (int ai = 0; ai < 2; ++ai)
#pragma unroll
            for (int m = 0; m < 4; ++m) { bf16_t* rowp = G + (size_t)(row0 + ai * HALF + m * 16) * 2048 + col0;
#pragma unroll
                for (int bj = 0; bj < 2; ++bj) {
                    const u32x4 gw = *(const u32x4*)(rowp + bj * HALF + (SECOND ? 1024 : 0));
                    const f32x4 a0 = acc[ai][bj][m][0], a1 = acc[ai][bj][m][1];
                    f32x4 v0 = {bf_lo(gw.x) * a0[0], bf_hi(gw.x) * a0[1], bf_lo(gw.y) * a0[2], bf_hi(gw.y) * a0[3]};
                    f32x4 v1 = {bf_lo(gw.z) * a1[0], bf_hi(gw.z) * a1[1], bf_lo(gw.w) * a1[2], bf_hi(gw.w) * a1[3]};
                    if (SECOND) { const u32x4 pw = *(const u32x4*)(rowp + bj * HALF);
                        v0 += (f32x4){bf_lo(pw.x), bf_hi(pw.x), bf_lo(pw.y), bf_hi(pw.y)}; v1 += (f32x4){bf_lo(pw.z), bf_hi(pw.z), bf_lo(pw.w), bf_hi(pw.w)}; }
                    *(u32x4*)(rowp + bj * HALF) = pack8(v0, v1); }
                PG8_ROWFENCE(); }
    }
};
struct EpiFF1 {
    static constexpr bool PERM = true, AFTER_DRAIN = false;
    bf16_t* H; const float* bias;
    __device__ __forceinline__ void operator()(const f32x4 (&acc)[2][2][4][2], const Unit& u, int wr, int wc, int fr, int fq) const {
        const int row0 = u.pm * BM + wr * 64 + fr, col0 = u.pn * BM + wc * 32 + 8 * fq;
        f32x4 bv[2][2];
#pragma unroll
        for (int bj = 0; bj < 2; ++bj)
#pragma unroll
            for (int n = 0; n < 2; ++n) bv[bj][n] = *(const f32x4*)(bias + col0 + bj * HALF + 4 * n);
#pragma unroll
        for (int ai = 0; ai < 2; ++ai)
#pragma unroll
            for (int m = 0; m < 4; ++m) { bf16_t* rowp = H + (size_t)(row0 + ai * HALF + m * 16) * 4096 + col0;
#pragma unroll
                for (int bj = 0; bj < 2; ++bj) { f32x4 v0 = acc[ai][bj][m][0] + bv[bj][0], v1 = acc[ai][bj][m][1] + bv[bj][1];
#pragma unroll
                    for (int e = 0; e < 4; ++e) { v0[e] = fmaxf(v0[e], 0.f); v1[e] = fmaxf(v1[e], 0.f); }
                    *(u32x4*)(rowp + bj * HALF) = pack8(v0 * v0, v1 * v1); } }
    }
};
struct EpiRes {
    static constexpr bool PERM = false, AFTER_DRAIN = false;
    const float* resA; const float* resB; int splitRow; float* out; const float* bias; float alpha;
    __device__ __forceinline__ void operator()(const f32x4 (&acc)[2][2][4][2], const Unit& u, int wr, int wc, int fr, int fq) const {
        const int rowt = u.pm * BM; const int col0 = u.pn * BM + wc * 32 + 4 * fq;
        const float* rbase = rowt < splitRow ? resA + (size_t)rowt * 1024 : resB + (size_t)(rowt - splitRow) * 1024;
        float* obase = out + (size_t)rowt * 1024;
        f32x4 bv[2][2];
#pragma unroll
        for (int bj = 0; bj < 2; ++bj)
#pragma unroll
            for (int n = 0; n < 2; ++n) bv[bj][n] = bias ? *(const f32x4*)(bias + col0 + bj * HALF + n * 16) : (f32x4){0.f, 0.f, 0.f, 0.f};
#pragma unroll
        for (int ai = 0; ai < 2; ++ai)
#pragma unroll
            for (int m = 0; m < 4; ++m) { const size_t off = (size_t)(wr * 64 + fr + ai * HALF + m * 16) * 1024 + col0;
#pragma unroll
                for (int bj = 0; bj < 2; ++bj)
#pragma unroll
                    for (int n = 0; n < 2; ++n) { const f32x4 x = *(const f32x4*)(rbase + off + bj * HALF + n * 16);
                        *(f32x4*)(obase + off + bj * HALF + n * 16) = x * alpha + acc[ai][bj][m][n] + bv[bj][n]; }
                PG8_ROWFENCE(); }
    }
};

template <class Epi, class Sched, bool ALIGN_EPI = false, bool SP2 = false>
__device__ __forceinline__ void gemm_phase(PG8_LAS unsigned char* lds, const Gemm g, const Sched& S, const Epi& E) {
    int tid_ = threadIdx.x; asm volatile("" : "+v"(tid_));
    const int tid = tid_, wid = __builtin_amdgcn_readfirstlane(tid >> 6), lane = tid & 63, wr = wid >> 2, wc = wid & 3, fr = lane & 15, fq = lane >> 4;
    const int K = g.K, nt = K / BK;
    unsigned voffA[2], voffB[2];
#pragma unroll
    for (int i = 0; i < 2; ++i) { int R, C; stage_rc(tid * 16 + i * 8192, R, C); const int Rb = Epi::PERM ? ((R & ~31) + perm32(R & 31)) : R;
        voffA[i] = (unsigned)(R * g.lda + C) * 2u; voffB[i] = (unsigned)(Rb * g.ldb + C) * 2u; }
    const size_t kstep = (size_t)(BK * 2);
    const size_t hstepA = (size_t)HALF * g.lda * 2, hstepB = (size_t)HALF * g.ldb * 2;
    const size_t tstepA = 2 * hstepA, tstepB = 2 * hstepB;
    const unsigned ldsw = (unsigned)wid * 1024u;
    const int aoff = lds_byte(wr * 64 + fr, fq * 8), boff = lds_byte(wc * 32 + fr, fq * 8);
#define PG8_SA(b, h) (((b) * 2 + (h)) * HTB)
#define PG8_SB(b, h) ((4 + (b) * 2 + (h)) * HTB)
#define PG8_STAGE(bufoff, gbase, voff) do { _Pragma("unroll") for (int _i = 0; _i < 2; ++_i) \
        __builtin_amdgcn_global_load_lds((const unsigned*)((const char*)(gbase) + (voff)[_i]), (PG8_LAS unsigned*)(lds + (bufoff) + ldsw + _i * 8192), 16, 0, 0); } while (0)
#define PG8_LDA(dst, b, h) do { _Pragma("unroll") for (int m = 0; m < 4; ++m) _Pragma("unroll") for (int k = 0; k < 2; ++k) dst[m][k] = *(const PG8_LAS bf16x8*)(lds + PG8_SA(b, h) + aoff + m * 2048 + k * 1024); } while (0)
#define PG8_LDB(dst, b, h) do { _Pragma("unroll") for (int n = 0; n < 2; ++n) _Pragma("unroll") for (int k = 0; k < 2; ++k) dst[n][k] = *(const PG8_LAS bf16x8*)(lds + PG8_SB(b, h) + boff + n * 2048 + k * 1024); } while (0)
#define PG8_MMA(ai, bj, At, Bt) do { __builtin_amdgcn_s_setprio(1); _Pragma("unroll") for (int m = 0; m < 4; ++m) _Pragma("unroll") for (int n = 0; n < 2; ++n) _Pragma("unroll") for (int k = 0; k < 2; ++k) \
        acc[ai][bj][m][n] = __builtin_amdgcn_mfma_f32_16x16x32_bf16(Bt[n][k], At[m][k], acc[ai][bj][m][n], 0, 0, 0); __builtin_amdgcn_s_setprio(0); } while (0)
#define PG8_WAIT_V(n) asm volatile("s_waitcnt vmcnt(" #n ")" ::: "memory")
#define PG8_WAIT_L(n) asm volatile("s_waitcnt lgkmcnt(" #n ")" ::: "memory")
#define PG8_BAR __builtin_amdgcn_s_barrier()
#define PG8_SCHED __builtin_amdgcn_sched_barrier(0)
    Unit cur, nxt; int ui = 0;
    if (!S.next(0, cur)) return;
    f32x4 acc[2][2][4][2];
#pragma unroll
    for (int a = 0; a < 2; ++a)
#pragma unroll
        for (int b = 0; b < 2; ++b)
#pragma unroll
            for (int m = 0; m < 4; ++m)
#pragma unroll
                for (int n = 0; n < 2; ++n) acc[a][b][m][n] = (f32x4){0.f, 0.f, 0.f, 0.f};
    bf16x8 At[4][2], B0[2][2], B1[2][2];
    const char* cA = (const char*)g.A + (size_t)cur.pm * tstepA; const char* cB = (const char*)g.Bt + (size_t)cur.pn * tstepB;
    S.a_ready(cur);
    if constexpr (SP2) {
        PG8_STAGE(PG8_SB(0, 0), cB, voffB); PG8_STAGE(PG8_SB(0, 1), cB + hstepB, voffB); PG8_STAGE(PG8_SA(0, 0), cA, voffA); PG8_STAGE(PG8_SA(0, 1), cA + hstepA, voffA);
        if (wr == 1) PG8_BAR;
        PG8_WAIT_V(2); PG8_BAR;
        PG8_STAGE(PG8_SB(1, 0), cB + kstep, voffB); PG8_STAGE(PG8_SA(1, 0), cA + kstep, voffA); PG8_STAGE(PG8_SB(1, 1), cB + hstepB + kstep, voffB);
        PG8_WAIT_V(6); PG8_BAR;
    } else {
        PG8_STAGE(PG8_SB(0, 0), cB, voffB); PG8_STAGE(PG8_SA(0, 0), cA, voffA); PG8_STAGE(PG8_SB(0, 1), cB + hstepB, voffB); PG8_STAGE(PG8_SA(0, 1), cA + hstepA, voffA);
        if (wr == 1) PG8_BAR;
        PG8_WAIT_V(4); PG8_BAR;
        PG8_STAGE(PG8_SB(1, 0), cB + kstep, voffB); PG8_STAGE(PG8_SA(1, 0), cA + kstep, voffA); PG8_STAGE(PG8_SB(1, 1), cB + hstepB + kstep, voffB);
        PG8_WAIT_V(6); PG8_BAR;
    }
    for (;;) {
        const bool has_next = S.next(ui + 1, nxt);
        const char* nA = has_next ? (const char*)g.A + (size_t)nxt.pm * tstepA : cA; const char* nB = has_next ? (const char*)g.Bt + (size_t)nxt.pn * tstepB : cB;
        for (int t = 0; t < nt; t += 2) {
            const bool last = (t == nt - 2);
            const char* a1 = cA + (size_t)(t + 1) * kstep;
            const char* a2 = last ? nA : cA + (size_t)(t + 2) * kstep; const char* b2 = last ? nB : cB + (size_t)(t + 2) * kstep;
            const char* a3 = a2 + kstep; const char* b3 = b2 + kstep;
            if (last && has_next) S.a_ready(nxt);
            if constexpr (SP2) {
            PG8_LDB(B0, 0, 0); PG8_LDB(B1, 0, 1); PG8_SCHED; PG8_LDA(At, 0, 0); PG8_STAGE(PG8_SA(1, 1), a1 + hstepA, voffA);
            PG8_WAIT_V(8); PG8_WAIT_L(0); PG8_BAR; PG8_MMA(0, 0, At, B0); PG8_MMA(0, 1, At, B1); PG8_BAR; PG8_SCHED;
            PG8_LDA(At, 0, 1); PG8_STAGE(PG8_SB(0, 0), b2, voffB); PG8_STAGE(PG8_SB(0, 1), b2 + hstepB, voffB); PG8_STAGE(PG8_SA(0, 0), a2, voffA);
            PG8_WAIT_V(8); PG8_WAIT_L(0); PG8_BAR; PG8_MMA(1, 0, At, B0); PG8_MMA(1, 1, At, B1); PG8_BAR; PG8_SCHED;
            PG8_LDB(B0, 1, 0); PG8_LDB(B1, 1, 1); PG8_SCHED; PG8_LDA(At, 1, 0); PG8_STAGE(PG8_SA(0, 1), a2 + hstepA, voffA);
            PG8_WAIT_V(8); PG8_WAIT_L(0); PG8_BAR; PG8_MMA(0, 0, At, B0); PG8_MMA(0, 1, At, B1); PG8_BAR; PG8_SCHED;
            PG8_LDA(At, 1, 1); PG8_STAGE(PG8_SB(1, 0), b3, voffB); PG8_STAGE(PG8_SB(1, 1), b3 + hstepB, voffB); PG8_STAGE(PG8_SA(1, 0), a3, voffA);
            PG8_WAIT_V(8); PG8_WAIT_L(0); PG8_BAR; PG8_MMA(1, 0, At, B0); PG8_MMA(1, 1, At, B1); PG8_BAR; PG8_SCHED;
            } else {
            PG8_LDB(B0, 0, 0); PG8_SCHED; PG8_LDA(At, 0, 0); PG8_STAGE(PG8_SA(1, 1), a1 + hstepA, voffA);
            PG8_WAIT_L(8); PG8_BAR; PG8_WAIT_L(0); PG8_MMA(0, 0, At, B0); PG8_BAR; PG8_SCHED;
            PG8_LDB(B1, 0, 1); PG8_STAGE(PG8_SB(0, 0), b2, voffB);
            PG8_BAR; PG8_WAIT_L(0); PG8_MMA(0, 1, At, B1); PG8_BAR;
            PG8_LDA(At, 0, 1); PG8_STAGE(PG8_SA(0, 0), a2, voffA);
            PG8_BAR; PG8_WAIT_L(0); PG8_MMA(1, 0, At, B0); PG8_BAR; PG8_SCHED;
            PG8_STAGE(PG8_SB(0, 1), b2 + hstepB, voffB);
            PG8_WAIT_V(6); PG8_BAR; PG8_MMA(1, 1, At, B1); PG8_BAR;
            PG8_LDB(B0, 1, 0); PG8_SCHED; PG8_LDA(At, 1, 0); PG8_STAGE(PG8_SA(0, 1), a2 + hstepA, voffA);
            PG8_WAIT_L(8); PG8_BAR; PG8_WAIT_L(0); PG8_MMA(0, 0, At, B0); PG8_BAR; PG8_SCHED;
            PG8_LDB(B1, 1, 1); PG8_STAGE(PG8_SB(1, 0), b3, voffB);
            PG8_BAR; PG8_WAIT_L(0); PG8_MMA(0, 1, At, B1); PG8_BAR;
            PG8_LDA(At, 1, 1); PG8_STAGE(PG8_SA(1, 0), a3, voffA);
            PG8_BAR; PG8_WAIT_L(0); PG8_MMA(1, 0, At, B0); PG8_BAR; PG8_SCHED;
            PG8_STAGE(PG8_SB(1, 1), b3 + hstepB, voffB);
            PG8_WAIT_V(6); PG8_BAR; PG8_MMA(1, 1, At, B1); PG8_BAR;
            }
        }
        if constexpr (ALIGN_EPI) { if (wr == 0) PG8_BAR; }
        if constexpr (!Epi::AFTER_DRAIN) { E(acc, cur, wr, wc, fr, fq); S.done(cur); }
        if (!has_next) break;
#pragma unroll
        for (int a = 0; a < 2; ++a)
#pragma unroll
            for (int b = 0; b < 2; ++b)
#pragma unroll
                for (int m = 0; m < 4; ++m)
#pragma unroll
                    for (int n = 0; n < 2; ++n) acc[a][b][m][n] = (f32x4){0.f, 0.f, 0.f, 0.f};
        cur = nxt; cA = nA; cB = nB; ++ui;
        if constexpr (ALIGN_EPI) { if (wr == 1) PG8_BAR; }
    }
    PG8_WAIT_V(0);
    if constexpr (!ALIGN_EPI) { if (wr == 0) PG8_BAR; }
    PG8_BAR;
    if constexpr (Epi::AFTER_DRAIN) { E.fused(acc, cur, wr, wc, fr, fq, lds, wid, lane); S.done(cur); }
#undef PG8_SA
#undef PG8_SB
#undef PG8_STAGE
#undef PG8_LDA
#undef PG8_LDB
#undef PG8_MMA
#undef PG8_WAIT_V
#undef PG8_WAIT_L
#undef PG8_BAR
#undef PG8_SCHED
}
}

namespace att {
#define ATT_LAS __attribute__((address_space(3)))
typedef unsigned short bf16_t;
typedef short bf16x8 __attribute__((ext_vector_type(8)));
typedef short s16x4 __attribute__((ext_vector_type(4)));
typedef float f32x16 __attribute__((ext_vector_type(16)));
typedef unsigned u32x4 __attribute__((ext_vector_type(4)));
typedef unsigned u32x2 __attribute__((ext_vector_type(2)));
typedef ATT_LAS unsigned char* ldsp;
constexpr float LOG2E = 1.4426950408889634f;
constexpr float QSCALE = 0.125f * LOG2E;
constexpr float LN_EPS = 1e-5f;
#define ATT_MFMA(a, b, c) __builtin_amdgcn_mfma_f32_32x32x16_bf16((a), (b), (c), 0, 0, 0)
__device__ __forceinline__ s16x4 vtr(ldsp p) { return __builtin_bit_cast(s16x4, __builtin_amdgcn_ds_read_tr16_b64_v4i16((ATT_LAS s16x4*)p)); }
__device__ __forceinline__ bf16x8 pack_frag(const f32x16& x, int s8) {
    u32x4 p; p.x = pg8::pk_bf16(x[s8], x[s8 + 1]); p.y = pg8::pk_bf16(x[s8 + 2], x[s8 + 3]); p.z = pg8::pk_bf16(x[s8 + 4], x[s8 + 5]); p.w = pg8::pk_bf16(x[s8 + 6], x[s8 + 7]);
    return __builtin_bit_cast(bf16x8, p);
}
__device__ __forceinline__ int voff(int key, int ch  ) { return (ch >> 2) * 4096 + (key >> 4) * 1024 + ((key >> 3) & 1) * 512 + (key & 7) * 64 + (ch & 3) * 16; }

constexpr int DKP = 272;
constexpr int DKBUF = 64 * DKP, DVBUF = 64 * 256, DBUF = DKBUF + DVBUF;
constexpr int DXOFF = 2 * DBUF;
constexpr int D_LDS = DXOFF + 65536;

__device__ __forceinline__ void diff_unit(ldsp lds, const bf16_t* Qp, const bf16_t* Kp, const bf16_t* Vp, bf16_t* Op,
                                          long rowbase, int S, int h, int qblk, float lam, const float* __restrict__ subln_g, const unsigned* stats  ) {
    int tid_ = threadIdx.x; asm volatile("" : "+v"(tid_));
    const int tid = tid_, lane = tid & 63, r = lane & 31, hh = lane >> 5;
    const int wid = __builtin_amdgcn_readfirstlane(tid >> 6), c = wid >> 2, qsub = wid & 3;
    const int q0 = qblk * 128, qpos = q0 + qsub * 32 + r;
    const float nslope2 = -LOG2E * __builtin_amdgcn_exp2f(-(float)(h + 1));
    bf16x8 qf[4];
    { const bf16_t* qptr = Qp + (size_t)(rowbase + qpos) * 1024 + h * 128 + c * 64 + hh * 8;
#pragma unroll
      for (int ks = 0; ks < 4; ++ks) qf[ks] = *(const bf16x8*)(qptr + ks * 16); }
    const int skey = tid >> 4, sch = tid & 15;
    const bf16_t* kg = Kp + (size_t)(rowbase + skey) * 1024 + h * 128 + sch * 8;
    const bf16_t* vg = Vp + (size_t)(rowbase + skey) * 1024 + h * 128 + sch * 8;
    const int NT = S / 64;
    int tlo, thi; bool fast;
    { float b2 = 0.f;
#pragma unroll
      for (int cc = 0; cc < 2; ++cc) { const float qn = __uint_as_float(stats[h * 4 + cc * 2]) + __uint_as_float(stats[h * 4 + cc * 2 + 1]);
          const float kn = __uint_as_float(stats[32 + h * 4 + cc * 2]) + __uint_as_float(stats[32 + h * 4 + cc * 2 + 1]); b2 = fmaxf(b2, qn * kn); }
      const float B = 1.02f * sqrtf(b2); fast = __builtin_amdgcn_readfirstlane((int)(B <= 60.f)) != 0;
      float dcf = (80.f + 2.f * B) / (-nslope2) + 2.f; if (!(dcf < (float)S)) dcf = (float)S;
      const int dc = (int)dcf; const int lo = q0 - dc, hi2 = q0 + 127 + dc;
      tlo = lo <= 0 ? 0 : (lo >> 6); thi = (hi2 >> 6) > NT - 1 ? NT - 1 : (hi2 >> 6);
      tlo = __builtin_amdgcn_readfirstlane(tlo); thi = __builtin_amdgcn_readfirstlane(thi); }
    const int kl0r = skey * DKP + sch * 16, kl1r = (skey + 32) * DKP + sch * 16, vl0r = voff(skey, sch), vl1r = voff(skey + 32, sch);
    float l = 0.f;
    f32x16 o[4];
#pragma unroll
    for (int eb = 0; eb < 4; ++eb)
#pragma unroll
        for (int i = 0; i < 16; ++i) o[eb][i] = 0.f;
    const int kread = r * DKP + c * 128 + hh * 16;
    const int vreadr = (4 * hh + ((lane & 15) >> 2)) * 64 + ((lane >> 4) & 1) * 32 + (lane & 3) * 8;
    if (fast) {
        const float slope2 = -nslope2; const int qw0 = q0 + qsub * 32;
        typedef float f32x2 __attribute__((ext_vector_type(2)));
        constexpr int RK = 0, RV = 65536, RS = 16384;
        const int krow = 4 * wid + (lane >> 4);
        const bf16_t* kgd = Kp + (size_t)(rowbase + krow) * 1024 + h * 128 + (((lane & 15) ^ (krow & 15)) * 8);
        const bf16_t* vgd = Vp + (size_t)(rowbase + 16 * (wid & 3) + (lane >> 2)) * 1024 + h * 128 + ((wid >> 2) * 4 + (lane & 3)) * 8;
#define DF_DMA(g, l) __builtin_amdgcn_global_load_lds((const unsigned*)(g), (ATT_LAS unsigned*)(l), 16, 0, 0)
#define DF_DMAK(tt, slot) do { const bf16_t* g_ = kgd + (size_t)(tt) * 64 * 1024; const ldsp l_ = lds + RK + (slot) * RS + wid * 1024; DF_DMA(g_, l_); DF_DMA(g_ + 32 * 1024, l_ + 8192); } while (0)
#define DF_DMAV(tt, slot) do { const bf16_t* g_ = vgd + (size_t)(tt) * 64 * 1024; const ldsp l_ = lds + RV + (slot) * RS + wid * 1024; DF_DMA(g_, l_); DF_DMA(g_ + 64, l_ + 8192); } while (0)
#define DF_CF(i) ((float)(((i) & 3) + 8 * ((i) >> 2)))
#define DF_INIT(S0, S1, tt) do { const int tb_ = (tt) * 64; const float db_ = (float)(tb_ + 4 * hh - qpos); \
        if (tb_ + 63 < qw0 || tb_ > qw0 + 31) { const float a_ = (tb_ + 63 < qw0) ? slope2 : -slope2, bl_ = (tt) > thi ? -INFINITY : a_ * db_;   \
            _Pragma("unroll") for (int i = 0; i < 16; ++i) { S0[i] = __builtin_fmaf(a_, DF_CF(i), bl_); S1[i] = __builtin_fmaf(a_, DF_CF(i) + 32.f, bl_); } } \
        else { _Pragma("unroll") for (int i = 0; i < 16; ++i) { S0[i] = nslope2 * __builtin_fabsf(db_ + DF_CF(i)); S1[i] = nslope2 * __builtin_fabsf(db_ + DF_CF(i) + 32.f); } } } while (0)
#define DF_VLOAD(ARR, vb, eb) do { _Pragma("unroll") for (int kk = 0; kk < 4; ++kk) { const s16x4 lo_ = vtr((vb) + (eb) * 4096 + kk * 1024), hi_ = vtr((vb) + (eb) * 4096 + kk * 1024 + 512); \
        ARR[kk] = __builtin_shufflevector(lo_, hi_, 0, 1, 2, 3, 4, 5, 6, 7); } } while (0)
#define DF_SB() __builtin_amdgcn_sched_barrier(0)
#define DF_CL(tt) ((tt) < thi ? (tt) : thi)
        f32x2 l2 = {0.f, 0.f};
        const int n = thi - tlo + 1;
        int koff[4];
#pragma unroll
        for (int ks = 0; ks < 4; ++ks) koff[ks] = r * 256 + (((c * 8 + 2 * ks + hh) ^ (r & 15)) << 4);
        DF_DMAK(tlo, 0); DF_DMAV(tlo, 3);
        DF_DMAK(DF_CL(tlo + 1), 1); DF_DMAV(tlo, 0);
        DF_DMAK(DF_CL(tlo + 2), 2); DF_DMAV(DF_CL(tlo + 1), 1);
        f32x16 sa0, sa1, sb0, sb1; bf16x8 pf[4];
#pragma unroll
        for (int i = 0; i < 16; ++i) { sa0[i] = 0.f; sa1[i] = 0.f; }
        const int n2 = n + (n & 1);
#define DF_SGB(mask, cnt) __builtin_amdgcn_sched_group_barrier((mask), (cnt), 0)
#define DF_PIN(x) asm volatile("" : "+v"(x))
#define DF_STEP(SO0, SO1, SN0, SN1, jj) do { \
            const int T_ = tlo + (jj); \
              \
            asm volatile("s_waitcnt vmcnt(8)" ::: "memory"); __builtin_amdgcn_s_barrier(); asm volatile("" ::: "memory"); \
            DF_DMAK(DF_CL(T_ + 3), ((jj) + 3) & 3); DF_DMAV(DF_CL(T_ + 2), ((jj) + 2) & 3); \
            DF_INIT(SN0, SN1, T_); \
            const ldsp kb_ = lds + RK + ((jj) & 3) * RS; \
            const ldsp vb_ = lds + RV + (((jj) + 3) & 3) * RS + vreadr; \
            bf16x8 kf[8], vA[4], vB[4]; \
            _Pragma("unroll") for (int ks = 0; ks < 4; ++ks) { kf[2 * ks] = *(const ATT_LAS bf16x8*)(kb_ + koff[ks]); kf[2 * ks + 1] = *(const ATT_LAS bf16x8*)(kb_ + koff[ks] + 8192); } \
            DF_VLOAD(vA, vb_, 0); \
            DF_SB(); \
              \
            _Pragma("unroll") for (int ks = 0; ks < 4; ++ks) { SN0 = ATT_MFMA(kf[2 * ks], qf[ks], SN0); SN1 = ATT_MFMA(kf[2 * ks + 1], qf[ks], SN1); } \
            _Pragma("unroll") for (int i = 0; i < 8; ++i) { l2 += (f32x2){SO0[2 * i], SO0[2 * i + 1]}; l2 += (f32x2){SO1[2 * i], SO1[2 * i + 1]}; } \
            pf[0] = pack_frag(SO0, 0); pf[1] = pack_frag(SO0, 8); pf[2] = pack_frag(SO1, 0); pf[3] = pack_frag(SO1, 8); \
            DF_VLOAD(vB, vb_, 1); \
            _Pragma("unroll") for (int g_ = 0; g_ < 8; ++g_) { DF_SGB(0x008, 1); DF_SGB(0x100, 1); DF_SGB(0x002, 4); } \
            DF_SB(); \
              \
            _Pragma("unroll") for (int kk = 0; kk < 4; ++kk) o[0] = ATT_MFMA(vA[kk], pf[kk], o[0]); \
            _Pragma("unroll") for (int i = 0; i < 8; ++i) SN0[i] = __builtin_amdgcn_exp2f(SN0[i]); \
            DF_VLOAD(vA, vb_, 2); \
            _Pragma("unroll") for (int g_ = 0; g_ < 4; ++g_) { DF_SGB(0x008, 1); DF_SGB(0x400, 2); DF_SGB(0x100, 2); } \
            DF_PIN(SN0); DF_SB(); \
              \
            _Pragma("unroll") for (int kk = 0; kk < 4; ++kk) o[1] = ATT_MFMA(vB[kk], pf[kk], o[1]); \
            _Pragma("unroll") for (int i = 8; i < 16; ++i) SN0[i] = __builtin_amdgcn_exp2f(SN0[i]); \
            DF_VLOAD(vB, vb_, 3); \
            _Pragma("unroll") for (int g_ = 0; g_ < 4; ++g_) { DF_SGB(0x008, 1); DF_SGB(0x400, 2); DF_SGB(0x100, 2); } \
            DF_PIN(SN0); DF_SB(); \
              \
            _Pragma("unroll") for (int kk = 0; kk < 4; ++kk) o[2] = ATT_MFMA(vA[kk], pf[kk], o[2]); \
            _Pragma("unroll") for (int i = 0; i < 8; ++i) SN1[i] = __builtin_amdgcn_exp2f(SN1[i]); \
            _Pragma("unroll") for (int g_ = 0; g_ < 4; ++g_) { DF_SGB(0x008, 1); DF_SGB(0x400, 2); } \
            DF_PIN(SN1); DF_SB(); \
              \
            _Pragma("unroll") for (int kk = 0; kk < 4; ++kk) o[3] = ATT_MFMA(vB[kk], pf[kk], o[3]); \
            _Pragma("unroll") for (int i = 8; i < 16; ++i) SN1[i] = __builtin_amdgcn_exp2f(SN1[i]); \
            _Pragma("unroll") for (int g_ = 0; g_ < 4; ++g_) { DF_SGB(0x008, 1); DF_SGB(0x400, 2); } \
            DF_PIN(SN1); DF_SB(); \
        } while (0)
        for (int j = 0; j < n2; j += 2) {
            DF_STEP(sa0, sa1, sb0, sb1, j);
            DF_STEP(sb0, sb1, sa0, sa1, j + 1);
        }
#undef DF_STEP
#undef DF_SGB
#undef DF_PIN
        asm volatile("s_waitcnt vmcnt(0)" ::: "memory"); __builtin_amdgcn_s_barrier(); asm volatile("" ::: "memory");
#pragma unroll
        for (int i = 0; i < 8; ++i) { l2 += (f32x2){sa0[2 * i], sa0[2 * i + 1]}; l2 += (f32x2){sa1[2 * i], sa1[2 * i + 1]}; }
        pf[0] = pack_frag(sa0, 0); pf[1] = pack_frag(sa0, 8); pf[2] = pack_frag(sa1, 0); pf[3] = pack_frag(sa1, 8);
        { const ldsp vb_ = lds + RV + ((n2 - 1) & 3) * RS + vreadr;
#pragma unroll
          for (int eb = 0; eb < 4; ++eb)
#pragma unroll
              for (int kk = 0; kk < 4; ++kk) { const s16x4 lo_ = vtr(vb_ + eb * 4096 + kk * 1024), hi_ = vtr(vb_ + eb * 4096 + kk * 1024 + 512);
                  o[eb] = ATT_MFMA(__builtin_shufflevector(lo_, hi_, 0, 1, 2, 3, 4, 5, 6, 7), pf[kk], o[eb]); } }
        l = l2.x + l2.y;
        __syncthreads();
#undef DF_DMA
#undef DF_DMAK
#undef DF_DMAV
#undef DF_CF
#undef DF_INIT
#undef DF_VLOAD
#undef DF_SB
#undef DF_CL
    } else {
    u32x4 sk0, sk1, sv0, sv1;
    const int kl0 = kl0r, kl1 = kl1r, vl0 = DKBUF + vl0r, vl1 = DKBUF + vl1r, vread = DKBUF + vreadr;
    float m = -1e30f;
    { const size_t go = (size_t)tlo * 64 * 1024;
      sk0 = *(const u32x4*)(kg + go); sk1 = *(const u32x4*)(kg + go + 32 * 1024); sv0 = *(const u32x4*)(vg + go); sv1 = *(const u32x4*)(vg + go + 32 * 1024); }
    *(ATT_LAS u32x4*)(lds + kl0) = sk0; *(ATT_LAS u32x4*)(lds + kl1) = sk1; *(ATT_LAS u32x4*)(lds + vl0) = sv0; *(ATT_LAS u32x4*)(lds + vl1) = sv1;
    __syncthreads();
    for (int t = tlo; t <= thi; ++t) {
        const int bsel = (t - tlo) & 1;
        const ldsp cur = lds + bsel * DBUF;
        const bool more = (t < thi);
        if (more) { const size_t go = (size_t)(t + 1) * 64 * 1024;
            sk0 = *(const u32x4*)(kg + go); sk1 = *(const u32x4*)(kg + go + 32 * 1024); sv0 = *(const u32x4*)(vg + go); sv1 = *(const u32x4*)(vg + go + 32 * 1024); }
        f32x16 s0, s1;
#pragma unroll
        for (int i = 0; i < 16; ++i) { s0[i] = 0.f; s1[i] = 0.f; }
#pragma unroll
        for (int ks = 0; ks < 4; ++ks) {
            const bf16x8 k0 = *(const ATT_LAS bf16x8*)(cur + kread + ks * 32);
            const bf16x8 k1 = *(const ATT_LAS bf16x8*)(cur + kread + 32 * DKP + ks * 32);
            s0 = ATT_MFMA(k0, qf[ks], s0); s1 = ATT_MFMA(k1, qf[ks], s1);
        }
        const float dbase = (float)(t * 64 + 4 * hh - qpos);
        float mx = -1e30f;
#pragma unroll
        for (int i = 0; i < 16; ++i) { const float d0 = dbase + (float)((i & 3) + 8 * (i >> 2));
            s0[i] = __builtin_fmaf(nslope2, __builtin_fabsf(d0), s0[i]); s1[i] = __builtin_fmaf(nslope2, __builtin_fabsf(d0 + 32.f), s1[i]);
            mx = fmaxf(mx, fmaxf(s0[i], s1[i])); }
        mx = fmaxf(mx, __shfl_xor(mx, 32));
        if (__any(mx > m)) { const float mn = fmaxf(m, mx), al = __builtin_amdgcn_exp2f(m - mn); m = mn; l *= al;
#pragma unroll
            for (int eb = 0; eb < 4; ++eb) o[eb] *= al; }
        float rs = 0.f;
#pragma unroll
        for (int i = 0; i < 16; ++i) { s0[i] = __builtin_amdgcn_exp2f(s0[i] - m); s1[i] = __builtin_amdgcn_exp2f(s1[i] - m); rs += s0[i] + s1[i]; }
        l += rs;
        bf16x8 pf[4]; pf[0] = pack_frag(s0, 0); pf[1] = pack_frag(s0, 8); pf[2] = pack_frag(s1, 0); pf[3] = pack_frag(s1, 8);
#pragma unroll
        for (int eb = 0; eb < 4; ++eb)
#pragma unroll
            for (int kk = 0; kk < 4; ++kk) {
                const s16x4 lo = vtr(cur + vread + eb * 4096 + kk * 1024), hi = vtr(cur + vread + eb * 4096 + kk * 1024 + 512);
                const bf16x8 vf = __builtin_shufflevector(lo, hi, 0, 1, 2, 3, 4, 5, 6, 7);
                o[eb] = ATT_MFMA(vf, pf[kk], o[eb]);
            }
        if (more) { const ldsp nx = lds + (bsel ^ 1) * DBUF;
            *(ATT_LAS u32x4*)(nx + kl0) = sk0; *(ATT_LAS u32x4*)(nx + kl1) = sk1; *(ATT_LAS u32x4*)(nx + vl0) = sv0; *(ATT_LAS u32x4*)(nx + vl1) = sv1; }
        __syncthreads();
    }
    }
    l += __shfl_xor(l, 32);
    const float inv = 1.f / l;
    ATT_LAS float* X = (ATT_LAS float*)(lds + DXOFF) + qsub * 4096 + lane;
    if (c == 1) {
#pragma unroll
        for (int eb = 0; eb < 4; ++eb)
#pragma unroll
            for (int i = 0; i < 16; ++i) X[(eb * 16 + i) * 64] = o[eb][i] * inv;
    }
    __syncthreads();
    if (c == 0) {
        float ss = 0.f;
#pragma unroll
        for (int eb = 0; eb < 4; ++eb)
#pragma unroll
            for (int i = 0; i < 16; ++i) { const float v = o[eb][i] * inv - lam * X[(eb * 16 + i) * 64]; o[eb][i] = v; ss += v * v; }
        ss += __shfl_xor(ss, 32);
        const float rn = 0.8f * __builtin_amdgcn_rsqf(ss * (1.f / 128.f) + LN_EPS);
        bf16_t* orow = Op + (size_t)(rowbase + qpos) * 1024 + h * 128 + 4 * hh;
#pragma unroll
        for (int eb = 0; eb < 4; ++eb)
#pragma unroll
            for (int g4 = 0; g4 < 4; ++g4) { const int e0 = eb * 32 + 8 * g4;
                const float4 gv = *(const float4*)(subln_g + e0 + 4 * hh);
                u32x2 w; w.x = pg8::pk_bf16(o[eb][4 * g4] * rn * gv.x, o[eb][4 * g4 + 1] * rn * gv.y); w.y = pg8::pk_bf16(o[eb][4 * g4 + 2] * rn * gv.z, o[eb][4 * g4 + 3] * rn * gv.w);
                *(u32x2*)(orow + e0) = w; }
    }
    __syncthreads();
}

constexpr int WKP = 144;
constexpr int WKBUF = 64 * WKP, WVBUF = 64 * 128, WBUF = WKBUF + WVBUF;

__device__ __forceinline__ void win_unit(ldsp lds, const bf16_t* Qp, const bf16_t* Kp, const bf16_t* Vp, bf16_t* Op,
                                         long rowbase, int S, int g, int qblk, const float* __restrict__ sink) {
    int tid_ = threadIdx.x; asm volatile("" : "+v"(tid_));
    const int tid = tid_, lane = tid & 63, r = lane & 31, hh = lane >> 5;
    const int wid = __builtin_amdgcn_readfirstlane(tid >> 6), hq = g * 4 + (wid & 3);
    const int q0 = qblk * 64, qw0 = q0 + (wid >> 2) * 32, qpos = qw0 + r;
    const float nslope2 = -LOG2E * __builtin_amdgcn_exp2f(-0.5f * (float)(hq + 1));
    bf16x8 qf[4];
    { const bf16_t* qptr = Qp + (size_t)(rowbase + qpos) * 1024 + hq * 64 + hh * 8;
#pragma unroll
      for (int ks = 0; ks < 4; ++ks) qf[ks] = *(const bf16x8*)(qptr + ks * 16); }
    const int skey = tid >> 3, sch = tid & 7;
    const bf16_t* kg = Kp + (size_t)(rowbase + skey) * 256 + g * 64 + sch * 8;
    const bf16_t* vg = Vp + (size_t)(rowbase + skey) * 256 + g * 64 + sch * 8;
    const int kl = skey * WKP + sch * 16, vl = WKBUF + voff(skey, sch);
    const int NT = S / 64;
    int tlo = q0 / 64 - 2; if (tlo < 0) tlo = 0;
    int thi = q0 / 64 + 2; if (thi > NT - 1) thi = NT - 1;
    u32x4 sk, sv;
    sk = *(const u32x4*)(kg + (size_t)tlo * 64 * 256); sv = *(const u32x4*)(vg + (size_t)tlo * 64 * 256);
    *(ATT_LAS u32x4*)(lds + kl) = sk; *(ATT_LAS u32x4*)(lds + vl) = sv;
    __syncthreads();
    float m = -1e30f, l = 0.f;
    f32x16 o[2];
#pragma unroll
    for (int eb = 0; eb < 2; ++eb)
#pragma unroll
        for (int i = 0; i < 16; ++i) o[eb][i] = 0.f;
    const int kread = r * WKP + hh * 16;
    const int vread = WKBUF + (4 * hh + ((lane & 15) >> 2)) * 64 + ((lane >> 4) & 1) * 32 + (lane & 3) * 8;
    for (int t = tlo; t <= thi; ++t) {
        const int b = (t - tlo) & 1;
        const ldsp cur = lds + b * WBUF;
        const bool more = (t < thi);
        if (more) { const size_t go = (size_t)(t + 1) * 64 * 256; sk = *(const u32x4*)(kg + go); sv = *(const u32x4*)(vg + go); }
        const bool active = (t * 64 + 63 >= qw0 - 128) && (t * 64 <= qw0 + 31 + 128);
        if (active) {
            f32x16 s0, s1;
#pragma unroll
            for (int i = 0; i < 16; ++i) { s0[i] = 0.f; s1[i] = 0.f; }
#pragma unroll
            for (int ks = 0; ks < 4; ++ks) {
                const bf16x8 k0 = *(const ATT_LAS bf16x8*)(cur + kread + ks * 32);
                const bf16x8 k1 = *(const ATT_LAS bf16x8*)(cur + kread + 32 * WKP + ks * 32);
                s0 = ATT_MFMA(k0, qf[ks], s0); s1 = ATT_MFMA(k1, qf[ks], s1);
            }
            const float dbase = (float)(t * 64 + 4 * hh - qpos);
            float mx = -INFINITY;
#pragma unroll
            for (int i = 0; i < 16; ++i) { const float d0 = __builtin_fabsf(dbase + (float)((i & 3) + 8 * (i >> 2))), d1 = __builtin_fabsf(dbase + (float)(32 + (i & 3) + 8 * (i >> 2)));
                s0[i] = d0 <= 128.f ? __builtin_fmaf(nslope2, d0, s0[i]) : -INFINITY; s1[i] = d1 <= 128.f ? __builtin_fmaf(nslope2, d1, s1[i]) : -INFINITY;
                mx = fmaxf(mx, fmaxf(s0[i], s1[i])); }
            mx = fmaxf(mx, __shfl_xor(mx, 32));
            if (__any(mx > m)) { const float mn = fmaxf(m, mx), al = __builtin_amdgcn_exp2f(m - mn); m = mn; l *= al;
#pragma unroll
                for (int eb = 0; eb < 2; ++eb) o[eb] *= al; }
            float rs = 0.f;
#pragma unroll
            for (int i = 0; i < 16; ++i) { s0[i] = __builtin_amdgcn_exp2f(s0[i] - m); s1[i] = __builtin_amdgcn_exp2f(s1[i] - m); rs += s0[i] + s1[i]; }
            l += rs;
            bf16x8 pf[4]; pf[0] = pack_frag(s0, 0); pf[1] = pack_frag(s0, 8); pf[2] = pack_frag(s1, 0); pf[3] = pack_frag(s1, 8);
#pragma unroll
            for (int eb = 0; eb < 2; ++eb)
#pragma unroll
                for (int kk = 0; kk < 4; ++kk) {
                    const s16x4 lo = vtr(cur + vread + eb * 4096 + kk * 1024), hi = vtr(cur + vread + eb * 4096 + kk * 1024 + 512);
                    const bf16x8 vf = __builtin_shufflevector(lo, hi, 0, 1, 2, 3, 4, 5, 6, 7);
                    o[eb] = ATT_MFMA(vf, pf[kk], o[eb]);
                }
        }
        if (more) { const ldsp nx = lds + (b ^ 1) * WBUF; *(ATT_LAS u32x4*)(nx + kl) = sk; *(ATT_LAS u32x4*)(nx + vl) = sv; }
        __syncthreads();
    }
    l += __shfl_xor(l, 32);
    const float sk2 = sink[hq] * LOG2E, mf = fmaxf(m, sk2), sc = __builtin_amdgcn_exp2f(m - mf);
    const float inv = sc / (l * sc + __builtin_amdgcn_exp2f(sk2 - mf));
    bf16_t* orow = Op + (size_t)(rowbase + qpos) * 1024 + hq * 64 + 4 * hh;
#pragma unroll
    for (int eb = 0; eb < 2; ++eb)
#pragma unroll
        for (int g4 = 0; g4 < 4; ++g4) { const int e0 = eb * 32 + 8 * g4;
            u32x2 w; w.x = pg8::pk_bf16(o[eb][4 * g4] * inv, o[eb][4 * g4 + 1] * inv); w.y = pg8::pk_bf16(o[eb][4 * g4 + 2] * inv, o[eb][4 * g4 + 3] * inv);
            *(u32x2*)(orow + e0) = w; }
}
}

#define LAS __attribute__((address_space(3)))
typedef unsigned short bf16;
typedef unsigned v4u __attribute__((ext_vector_type(4)));
typedef float f32x4 __attribute__((ext_vector_type(4)));
constexpr int NWAVES = 8;
constexpr int T_P = 8 * 8192, T_S = 2 * 16384, T_ALL = T_P + T_S;
constexpr int DM = 1024, DFF = 4096, IN_COLS = 6656, QKV_COLS = 4608, GATE_COLS = 2048;
constexpr float DN_ALPHA = 1.189207115002721f;
constexpr float LN_EPS = 1e-5f;
constexpr int LDS_BYTES = 147456;
static_assert(att::D_LDS <= LDS_BYTES && pg8::STAGE_BYTES <= LDS_BYTES, "LDS map");
constexpr size_t WS_WIN = 0;
constexpr size_t WS_WBRA = WS_WIN + (size_t)IN_COLS * DM * 2;
constexpr size_t WS_WBRB = WS_WBRA + (size_t)DM * DM * 2;
constexpr size_t WS_WOUT = WS_WBRB + (size_t)DM * DM * 2;
constexpr size_t WS_WFF1 = WS_WOUT + (size_t)DM * DM * 2;
constexpr size_t WS_WFF2 = WS_WFF1 + (size_t)DFF * DM * 2;
constexpr size_t WS_BIG = WS_WFF2 + (size_t)DFF * DM * 2;
constexpr size_t PLANE = (size_t)T_ALL * DM * 2;
constexpr size_t WS_PA = WS_BIG, WS_PB = WS_PA + PLANE, WS_PC = WS_PB + PLANE, WS_PD = WS_PC + PLANE;
constexpr size_t WS_TAIL = WS_PD + PLANE;
constexpr size_t WS_PE = WS_TAIL, WS_PF = WS_PE + (size_t)T_ALL * 256 * 2;
constexpr size_t WS_CTL = WS_TAIL + PLANE;
constexpr size_t WS_END = WS_CTL + 8192;
constexpr int LDS_CTL = 135168;
static_assert(att::D_LDS <= LDS_CTL && LDS_CTL + 16 <= 147456, "LDS ctl word");

__device__ __forceinline__ unsigned f2bf(float f) { unsigned u = __builtin_bit_cast(unsigned, f); return (u + 0x7fffu + ((u >> 16) & 1u)) >> 16; }
__device__ __forceinline__ unsigned pk2(float lo, float hi) { return f2bf(lo) | (f2bf(hi) << 16); }
__device__ __forceinline__ float wave_sum(float v) {
#pragma unroll
    for (int o = 1; o < 64; o <<= 1) v += __shfl_xor(v, o);
    return v;
}
__device__ __forceinline__ void p0_transpose_item(const float* W, int K, int N, bf16* WT, LAS float* scr, int item, int lane) {
    const int nblk = N / 32, kb = item / nblk, nb = item % nblk, k0 = 64 * kb, n0 = 32 * nb;
#pragma unroll 8
    for (int i = 0; i < 32; ++i) { const int kk = 2 * i + (lane >> 5); scr[kk * 33 + (lane & 31)] = W[(size_t)(k0 + kk) * N + n0 + (lane & 31)]; }
    asm volatile("s_waitcnt lgkmcnt(0)" ::: "memory");
    const int c = lane & 7;
#pragma unroll
    for (int j = 0; j < 4; ++j) { const int n = (lane >> 3) + 8 * j; const LAS float* s = scr + (8 * c) * 33 + n;
        v4u o; o.x = pk2(s[0 * 33], s[1 * 33]); o.y = pk2(s[2 * 33], s[3 * 33]); o.z = pk2(s[4 * 33], s[5 * 33]); o.w = pk2(s[6 * 33], s[7 * 33]);
        *(v4u*)(WT + (size_t)(n0 + n) * K + k0 + 8 * c) = o; }
    asm volatile("s_waitcnt lgkmcnt(0)" ::: "memory");
}
template <bool WITH_BF16> __device__ __forceinline__ void ln_rows(float* Z, bf16* Zb, const float* __restrict__ gam, const float* __restrict__ bet, int gw, int NGW, int lane) {
    f32x4 gv[4], bv[4];
#pragma unroll
    for (int j = 0; j < 4; ++j) { gv[j] = *((const f32x4*)gam + 64 * j + lane); bv[j] = *((const f32x4*)bet + 64 * j + lane); }
    for (int m = gw; m < T_ALL; m += NGW) {
        f32x4* zr = (f32x4*)(Z + (size_t)m * DM) + lane;
        f32x4 v[4]; float s = 0.f;
#pragma unroll
        for (int j = 0; j < 4; ++j) { v[j] = zr[64 * j]; s += (v[j].x + v[j].y) + (v[j].z + v[j].w); }
        const float mean = wave_sum(s) * (1.f / DM); float s2 = 0.f;
#pragma unroll
        for (int j = 0; j < 4; ++j) { v[j] = v[j] - mean; s2 += (v[j].x * v[j].x + v[j].y * v[j].y) + (v[j].z * v[j].z + v[j].w * v[j].w); }
        const float rstd = 1.f / sqrtf(wave_sum(s2) * (1.f / DM) + LN_EPS);
#pragma unroll
        for (int j = 0; j < 4; ++j) { const f32x4 y = v[j] * rstd * gv[j] + bv[j]; zr[64 * j] = y;
            if (WITH_BF16) { unsigned long long* o8 = (unsigned long long*)(Zb + (size_t)m * DM) + lane;
                o8[64 * j] = (unsigned long long)pk2(y.x, y.y) | ((unsigned long long)pk2(y.z, y.w) << 32); } }
    }
}

struct Args { const float* in[21]; float* out; unsigned char* ws; };

__global__ void __launch_bounds__(NWAVES * 64) fwd_megakernel(Args a) {
    extern __shared__ __attribute__((aligned(16))) unsigned char lds_raw[];
    cg::grid_group grid = cg::this_grid();
    LAS unsigned char* lds = (LAS unsigned char*)lds_raw;
    const int tid = threadIdx.x, lane = tid & 63, wave = __builtin_amdgcn_readfirstlane(tid >> 6);
    const int G = gridDim.x, bx = blockIdx.x;
    const int vcu = (G % 8 == 0) ? (bx % 8) * (G / 8) + bx / 8 : bx;
    const int gw = vcu * NWAVES + wave, NGW = G * NWAVES;
    unsigned char* ws = a.ws;
    bf16* WinT = (bf16*)(ws + WS_WIN); bf16* WbraT = (bf16*)(ws + WS_WBRA); bf16* WbrbT = (bf16*)(ws + WS_WBRB); bf16* WoutT = (bf16*)(ws + WS_WOUT);
    bf16* Wff1T = (bf16*)(ws + WS_WFF1); bf16* Wff2T = (bf16*)(ws + WS_WFF2);
    bf16* PA = (bf16*)(ws + WS_PA); bf16* PB = (bf16*)(ws + WS_PB); bf16* PC = (bf16*)(ws + WS_PC); bf16* PD = (bf16*)(ws + WS_PD);
    bf16* PE = (bf16*)(ws + WS_PE); bf16* PF = (bf16*)(ws + WS_PF);
    bf16* GM = PB;
    bf16* HB = PA;
    bf16* X1B = (bf16*)(ws + WS_TAIL);
    bf16* XB = (bf16*)a.out;
    float* OUT = a.out;

    unsigned* ctl = (unsigned*)(ws + WS_CTL);
    {
        if (bx == 0) for (int i = tid; i < 2048; i += NWAVES * 64) ctl[i] = 0u;
        LAS float* scr = (LAS float*)(lds + wave * 16384);
        constexpr int I_IN = (DM / 64) * (IN_COLS / 32), I_SQ = (DM / 64) * (DM / 32), I_F1 = (DM / 64) * (DFF / 32), I_F2 = (DFF / 64) * (DM / 32);
        constexpr int NITEMS = I_IN + 3 * I_SQ + I_F1 + I_F2;
        for (int it = gw; it < NITEMS; it += NGW) {
            int r = it;
            if (r < I_IN) { p0_transpose_item(a.in[2], DM, IN_COLS, WinT, scr, r, lane); continue; } r -= I_IN;
            if (r < I_SQ) { p0_transpose_item(a.in[10], DM, DM, WbraT, scr, r, lane); continue; } r -= I_SQ;
            if (r < I_SQ) { p0_transpose_item(a.in[11], DM, DM, WbrbT, scr, r, lane); continue; } r -= I_SQ;
            if (r < I_SQ) { p0_transpose_item(a.in[12], DM, DM, WoutT, scr, r, lane); continue; } r -= I_SQ;
            if (r < I_F1) { p0_transpose_item(a.in[15], DM, DFF, Wff1T, scr, r, lane); continue; } r -= I_F1;
            p0_transpose_item(a.in[17], DFF, DM, Wff2T, scr, r, lane);
        }
        const size_t n8 = (size_t)T_ALL * DM / 8, np8 = (size_t)T_P * DM / 8;
        for (size_t i = (size_t)vcu * (NWAVES * 64) + tid; i < n8; i += (size_t)G * (NWAVES * 64)) {
            const float* src = i < np8 ? a.in[0] + i * 8 : a.in[1] + (i - np8) * 8;
            const f32x4 v0 = *(const f32x4*)src, v1 = *(const f32x4*)(src + 4);
            v4u o; o.x = pk2(v0.x, v0.y); o.y = pk2(v0.z, v0.w); o.z = pk2(v1.x, v1.y); o.w = pk2(v1.z, v1.w);
            *(v4u*)(XB + i * 8) = o;
        }
    }
    grid.sync();

    {
        pg8::Gemm g{XB, WinT, T_ALL, QKV_COLS, DM, DM, DM}; pg8::StaticOrder S; S.init(T_ALL, QKV_COLS, G, bx);
        pg8::EpiQKV E{PA, PB, PC, PD, PE, PF, att::QSCALE, ctl};
        pg8::gemm_phase<pg8::EpiQKV, pg8::StaticOrder, true, true>(lds, g, S, E);
    }
    grid.sync();

    {
        float s1 = 0.f, s2 = 0.f;
        for (int i = 0; i < 64; ++i) { s1 += a.in[4][i] * a.in[5][i]; s2 += a.in[6][i] * a.in[7][i]; }
        const float lam = __expf(s1) - __expf(s2) + 0.2f;
        volatile LAS int* bcast = (volatile LAS int*)(lds + LDS_CTL);
        for (int qi = 0; qi < 8; ++qi) {
            const int x = (bx + qi) & 7;
            for (;;) {
                if (tid == 0) bcast[0] = (int)atomicAdd(ctl + 1024 + 64 * x, 1u);
                __syncthreads();
                const int i = __builtin_amdgcn_readfirstlane(bcast[0]);
                __syncthreads();
                if (i >= 768) break;
                const int si = i >> 5, w = i & 31, gi = si / 3, j = si - 3 * gi, h = 7 - gi, cs = (x + h) & 7;
                if (j == 0) { const int b = cs >> 2, part = cs & 3;
                    att::diff_unit(lds, PA, PB, PC, PA, (long)T_P + (long)b * 16384, 16384, h, part * 32 + w, lam, a.in[8], ctl + (8 + b) * 64); }
                else { const int cp = cs + 8 * (j - 1), b = cp >> 1, part = cp & 1;
                    att::diff_unit(lds, PA, PB, PC, PA, (long)b * 8192, 8192, h, part * 32 + w, lam, a.in[8], ctl + b * 64); }
            }
        }
        for (int it = vcu; it < 6144; it += G) {
            if (it < 4096) { const int b = it / (4 * 128), g = (it / 128) % 4, qb = it % 128;
                att::win_unit(lds, PD, PE, PF, PD, (long)b * 8192, 8192, g, qb, a.in[9]); }
            else { const int i2 = it - 4096; const int b = i2 / (4 * 256), g = (i2 / 256) % 4, qb = i2 % 256;
                att::win_unit(lds, PD, PE, PF, PD, (long)T_P + (long)b * 16384, 16384, g, qb, a.in[9]); }
        }
    }
    grid.sync();

    {
        pg8::Gemm g{XB, WinT + (size_t)QKV_COLS * DM, T_ALL, GATE_COLS, DM, DM, DM}; pg8::StaticOrder S; S.init(T_ALL, GATE_COLS, G, bx);
        pg8::EpiGate E{GM, a.in[3]};
        pg8::gemm_phase<pg8::EpiGate, pg8::StaticOrder, true, true>(lds, g, S, E);
    }
    grid.sync();

    {
        pg8::Gemm g{PA, WbraT, T_ALL, DM, DM, DM, DM}; pg8::StaticOrder S; S.init(T_ALL, DM, G, bx);
        pg8::EpiBranch<false> E{GM};
        pg8::gemm_phase<pg8::EpiBranch<false>, pg8::StaticOrder, true, true>(lds, g, S, E);
    }
    __syncthreads();
    {
        pg8::Gemm g{PD, WbrbT, T_ALL, DM, DM, DM, DM}; pg8::StaticOrder S; S.init(T_ALL, DM, G, bx);
        pg8::EpiBranch<true> E{GM};
        pg8::gemm_phase<pg8::EpiBranch<true>, pg8::StaticOrder, true, true>(lds, g, S, E);
    }
    grid.sync();

    {
        pg8::Gemm g{GM, WoutT, T_ALL, DM, DM, 2048, DM}; pg8::StaticOrder S; S.init(T_ALL, DM, G, bx);
        pg8::EpiRes E{a.in[0], a.in[1], T_P, OUT, nullptr, DN_ALPHA};
        pg8::gemm_phase<pg8::EpiRes, pg8::StaticOrder, true, true>(lds, g, S, E);
    }
    grid.sync();

    ln_rows<true>(OUT, X1B, a.in[13], a.in[14], gw, NGW, lane);
    grid.sync();

    {
        pg8::Gemm g{X1B, Wff1T, T_ALL, DFF, DM, DM, DM}; pg8::StaticOrder S; S.init(T_ALL, DFF, G, bx);
        pg8::EpiFF1 E{HB, a.in[16]};
        pg8::gemm_phase<pg8::EpiFF1, pg8::StaticOrder, true, true>(lds, g, S, E);
    }
    grid.sync();

    {
        pg8::Gemm g{HB, Wff2T, T_ALL, DM, DFF, DFF, DFF}; pg8::StaticOrder S; S.init(T_ALL, DM, G, bx);
        pg8::EpiRes E{OUT, OUT, 1 << 30, OUT, a.in[18], DN_ALPHA};
        pg8::gemm_phase<pg8::EpiRes, pg8::StaticOrder, true, true>(lds, g, S, E);
    }
    grid.sync();

    ln_rows<false>(OUT, nullptr, a.in[19], a.in[20], gw, NGW, lane);
}

extern "C" void kernel_launch(void* const* d_in, const int* in_sizes, int n_in, void* d_out, int out_size, void* d_ws, size_t ws_size, hipStream_t stream) {
    static int grid = 0;
    if (grid == 0) {
        if (n_in != 21 || out_size != T_ALL * DM || ws_size < WS_END) { fprintf(stderr, "kernel_launch: unexpected shapes (n_in %d, out %d, ws %zu < %zu)\n", n_in, out_size, ws_size, (size_t)WS_END); grid = -1; return; }
        int dev = 0, cus = 0, per_cu = 0;
        (void)hipGetDevice(&dev);
        (void)hipDeviceGetAttribute(&cus, hipDeviceAttributeMultiprocessorCount, dev);
        (void)hipFuncSetAttribute((const void*)fwd_megakernel, hipFuncAttributeMaxDynamicSharedMemorySize, LDS_BYTES);
        if (hipOccupancyMaxActiveBlocksPerMultiprocessor(&per_cu, (const void*)fwd_megakernel, NWAVES * 64, LDS_BYTES) != hipSuccess || per_cu < 1) per_cu = 1;
        (void)hipGetLastError();
        if (cus <= 0) cus = 256;
        grid = cus * per_cu;
    }
    if (grid < 0) return;
    Args a{};
    for (int i = 0; i < 21; ++i) a.in[i] = (const float*)d_in[i];
    a.out = (float*)d_out; a.ws = (unsigned char*)d_ws;
    void* args[] = {&a};
    hipError_t e = hipLaunchCooperativeKernel((const void*)fwd_megakernel, dim3(grid), dim3(NWAVES * 64), args, LDS_BYTES, stream);
    if (e != hipSuccess) fprintf(stderr, "cooperative launch failed: %s (grid %d)\n", hipGetErrorString(e), grid);
}
```

```cpp
#include <hip/hip_runtime.h>
#include <hip/hip_cooperative_groups.h>
#include <cstdio>
#include <cstdint>
namespace cg = cooperative_groups;

namespace pg8 {
#define PG8_LAS __attribute__((address_space(3)))
typedef unsigned short bf16_t;
typedef short bf16x8 __attribute__((ext_vector_type(8)));
typedef float f32x4 __attribute__((ext_vector_type(4)));
typedef unsigned u32x4 __attribute__((ext_vector_type(4)));
constexpr int BM = 256, BK = 64, HALF = 128, HTB = HALF * BK * 2  , STAGE_BYTES = 8 * HTB, NXCD = 8, WGM = 8;

__host__ __device__ __forceinline__ int lds_byte(int r, int c) { const int st = (r >> 4) * 2 + (c >> 5), rr = r & 15, cc = c & 31, ob = rr * 64 + cc * 2; return st * 1024 + (ob ^ (((ob >> 9) & 1) << 5)); }
__host__ __device__ __forceinline__ void stage_rc(int b, int& R, int& C) { const int st = b / 1024, sb = b % 1024, swz = sb ^ (((sb >> 9) & 1) << 5); R = (st >> 1) * 16 + swz / 64; C = (st & 1) * 32 + (swz % 64) / 2; }
__host__ __device__ __forceinline__ int perm32(int rho) { const int n = rho >> 4, i = rho & 15; return 8 * (i >> 2) + 4 * n + (i & 3); }

struct Unit { int pm, pn; };
struct Gemm { const bf16_t* A; const bf16_t* Bt; int M, N, K, lda, ldb; };

struct StaticOrder {
    int nM, nN, nwg, G, c;
    __host__ __device__ void init(int M, int N, int G_, int c_) { nM = M / BM; nN = N / BM; nwg = nM * nN; G = G_; c = c_; }
    __host__ __device__ bool next(int i, Unit& u) const {
        const long L = (long)i * G + c; if (L >= nwg) return false;
        int wgid = (int)L; { const int q = nwg / NXCD, r = nwg % NXCD, xcd = wgid % NXCD, off = wgid / NXCD; wgid = (xcd < r ? xcd * (q + 1) : r * (q + 1) + (xcd - r) * q) + off; }
        const int nig = WGM * nN, gid = wgid / nig, fm = gid * WGM, gsz = (nM - fm) < WGM ? (nM - fm) : WGM;
        u.pm = fm + ((wgid % nig) % gsz); u.pn = (wgid % nig) / gsz; return true;
    }
    __device__ __forceinline__ void a_ready(const Unit&) const {}
    __device__ __forceinline__ void done(const Unit&) const {}
};

typedef __bf16 bf16x2_t __attribute__((ext_vector_type(2)));
typedef float f32x2_t __attribute__((ext_vector_type(2)));
__device__ __forceinline__ unsigned pk_bf16(float lo, float hi) { f32x2_t v = {lo, hi}; bf16x2_t b = __builtin_convertvector(v, bf16x2_t); return __builtin_bit_cast(unsigned, b); }
__device__ __forceinline__ float bf_lo(unsigned w) { return __uint_as_float(w << 16); }
__device__ __forceinline__ float bf_hi(unsigned w) { return __uint_as_float(w & 0xffff0000u); }
__device__ __forceinline__ u32x4 pack8(const f32x4 a, const f32x4 b) { u32x4 w; w.x = pk_bf16(a[0], a[1]); w.y = pk_bf16(a[2], a[3]); w.z = pk_bf16(b[0], b[1]); w.w = pk_bf16(b[2], b[3]); return w; }
#define PG8_ROWFENCE() asm volatile("" ::: "memory")

struct EpiQKV {
    static constexpr bool PERM = true, AFTER_DRAIN = false;
    bf16_t *PA, *PB, *PC, *PD, *PE, *PF; float qscale; unsigned* stats;
    __device__ __forceinline__ void operator()(const f32x4 (&acc)[2][2][4][2], const Unit& u, int wr, int wc, int fr, int fq) const {
        const int pn = u.pn; bf16_t* base; int ld = 1024, cb; float sc = 1.f;
        if (pn < 8) {
            const float s0 = pn < 4 ? qscale : 1.f; float rmax[2] = {0.f, 0.f};
#pragma unroll
            for (int ai = 0; ai < 2; ++ai)
#pragma unroll
                for (int m = 0; m < 4; ++m)
#pragma unroll
                    for (int bj = 0; bj < 2; ++bj) { const f32x4 a = acc[ai][bj][m][0] * s0, b = acc[ai][bj][m][1] * s0;
                        float q = (a[0] * a[0] + a[1] * a[1]) + (a[2] * a[2] + a[3] * a[3]) + (b[0] * b[0] + b[1] * b[1]) + (b[2] * b[2] + b[3] * b[3]);
                        q += __shfl_xor(q, 16); q += __shfl_xor(q, 32); rmax[bj] = fmaxf(rmax[bj], q); }
#pragma unroll
            for (int bj = 0; bj < 2; ++bj) { float q = rmax[bj];
                q = fmaxf(q, __shfl_xor(q, 1)); q = fmaxf(q, __shfl_xor(q, 2)); q = fmaxf(q, __shfl_xor(q, 4)); q = fmaxf(q, __shfl_xor(q, 8));
                const int rowt = u.pm * BM, seq = rowt < 65536 ? (rowt >> 13) : 8 + ((rowt - 65536) >> 14);
                if (fr == 0 && fq == 0) atomicMax(stats + (seq * 2 + (pn >> 2)) * 32 + (pn & 3) * 8 + bj * 4 + wc, __float_as_uint(q)); }
        }
        if (pn < 4) { base = PA; cb = pn * 256; sc = qscale; }
        else if (pn < 8) { base = PB; cb = (pn - 4) * 256; }
        else if (pn < 12) { base = PC; cb = (pn - 8) * 256; }
        else if (pn < 16) { base = PD; cb = (pn - 12) * 256; sc = qscale; }
        else if (pn == 16) { base = PE; ld = 256; cb = 0; }
        else { base = PF; ld = 256; cb = 0; }
        const int row0 = u.pm * BM + wr * 64 + fr, col0 = cb + wc * 32 + 8 * fq;
#pragma unroll
        for (int ai = 0; ai < 2; ++ai)
#pragma unroll
            for (int m = 0; m < 4; ++m) { bf16_t* rowp = base + (size_t)(row0 + ai * HALF + m * 16) * ld + col0;
#pragma unroll
                for (int bj = 0; bj < 2; ++bj) *(u32x4*)(rowp + bj * HALF) = pack8(acc[ai][bj][m][0] * sc, acc[ai][bj][m][1] * sc); }
    }
};
struct EpiGate {
    static constexpr bool PERM = true, AFTER_DRAIN = false;
    bf16_t* G; const float* bias;
    __device__ __forceinline__ void operator()(const f32x4 (&acc)[2][2][4][2], const Unit& u, int wr, int wc, int fr, int fq) const {
        const int row0 = u.pm * BM + wr * 64 + fr, col0 = u.pn * BM + wc * 32 + 8 * fq;
        f32x4 bv[2][2];
#pragma unroll
        for (int bj = 0; bj < 2; ++bj)
#pragma unroll
            for (int n = 0; n < 2; ++n) bv[bj][n] = *(const f32x4*)(bias + col0 + bj * HALF + 4 * n);
#pragma unroll
        for (int ai = 0; ai < 2; ++ai)
#pragma unroll
            for (int m = 0; m < 4; ++m) { bf16_t* rowp = G + (size_t)(row0 + ai * HALF + m * 16) * 2048 + col0;
#pragma unroll
                for (int bj = 0; bj < 2; ++bj) { f32x4 v0 = acc[ai][bj][m][0] + bv[bj][0], v1 = acc[ai][bj][m][1] + bv[bj][1];
#pragma unroll
                    for (int e = 0; e < 4; ++e) { v0[e] = __builtin_amdgcn_rcpf(1.f + __expf(-v0[e])); v1[e] = __builtin_amdgcn_rcpf(1.f + __expf(-v1[e])); }
                    *(u32x4*)(rowp + bj * HALF) = pack8(v0, v1); } }
    }
};
template <bool SECOND> struct EpiBranch {
    static constexpr bool PERM = true, AFTER_DRAIN = false;
    bf16_t* G;
    __device__ __forceinline__ void operator()(const f32x4 (&acc)[2][2][4][2], const Unit& u, int wr, int wc, int fr, int fq) const {
        const int row0 = u.pm * BM + wr * 64 + fr, col0 = u.pn * BM + wc * 32 + 8 * fq;
#pragma unroll
        for (int ai = 0; ai < 2; ++ai)
#pragma unroll
            for (int m = 0; m < 4; ++m) { bf16_t* rowp = G + (size_t)(row0 + ai * HALF + m * 16) * 2048 + col0;
#pragma unroll
                for (int bj = 0; bj < 2; ++bj) {
                    const u32x4 gw = *(const u32x4*)(rowp + bj * HALF + (SECOND ? 1024 : 0));
                    const f32x4 a0 = acc[ai][bj][m][0], a1 = acc[ai][bj][m][1];
                    f32x4 v0 = {bf_lo(gw.x) * a0[0], bf_hi(gw.x) * a0[1], bf_lo(gw.y) * a0[2], bf_hi(gw.y) * a0[3]};
                    f32x4 v1 = {bf_lo(gw.z) * a1[0], bf_hi(gw.z) * a1[1], bf_lo(gw.w) * a1[2], bf_hi(gw.w) * a1[3]};
                    if (SECOND) { const u32x4 pw = *(const u32x4*)(rowp + bj * HALF);
                        v0 += (f32x4){bf_lo(pw.x), bf_hi(pw.x), bf_lo(pw.y), bf_hi(pw.y)}; v1 += (f32x4){bf_lo(pw.z), bf_hi(pw.z), bf_lo(pw.w), bf_hi(pw.w)}; }
                    *(u32x4*)(rowp + bj * HALF) = pack8(v0, v1); }
                PG8_ROWFENCE(); }
    }
};
struct EpiFF1 {
    static constexpr bool PERM = true, AFTER_DRAIN = false;
    bf16_t* H; const float* bias;
    __device__ __forceinline__ void operator()(const f32x4 (&acc)[2][2][4][2], const Unit& u, int wr, int wc, int fr, int fq) const {
        const int row0 = u.pm * BM + wr * 64 + fr, col0 = u.pn * BM + wc * 32 + 8 * fq;
        f32x4 bv[2][2];
#pragma unroll
        for (int bj = 0; bj < 2; ++bj)
#pragma unroll
            for (int n = 0; n < 2; ++n) bv[bj][n] = *(const f32x4*)(bias + col0 + bj * HALF + 4 * n);
#pragma unroll
        for (int ai = 0; ai < 2; ++ai)
#pragma unroll
            for (int m = 0; m < 4; ++m) { bf16_t* rowp = H + (size_t)(row0 + ai * HALF + m * 16) * 4096 + col0;
#pragma unroll
                for (int bj = 0; bj < 2; ++bj) { f32x4 v0 = acc[ai][bj][m][0] + bv[bj][0], v1 = acc[ai][bj][m][1] + bv[bj][1];
#pragma unroll
                    for (int e = 0; e < 4; ++e) { v0[e] = fmaxf(v0[e], 0.f); v1[e] = fmaxf(v1[e], 0.f); }
                    *(u32x4*)(rowp + bj * HALF) = pack8(v0 * v0, v1 * v1); } }
    }
};
struct EpiRes {
    static constexpr bool PERM = false, AFTER_DRAIN = false;
    const float* resA; const float* resB; int splitRow; float* out; const float* bias; float alpha;
    __device__ __forceinline__ void operator()(const f32x4 (&acc)[2][2][4][2], const Unit& u, int wr, int wc, int fr, int fq) const {
        const int rowt = u.pm * BM; const int col0 = u.pn * BM + wc * 32 + 4 * fq;
        const float* rbase = rowt < splitRow ? resA + (size_t)rowt * 1024 : resB + (size_t)(rowt - splitRow) * 1024;
        float* obase = out + (size_t)rowt * 1024;
        f32x4 bv[2][2];
#pragma unroll
        for (int bj = 0; bj < 2; ++bj)
#pragma unroll
            for (int n = 0; n < 2; ++n) bv[bj][n] = bias ? *(const f32x4*)(bias + col0 + bj * HALF + n * 16) : (f32x4){0.f, 0.f, 0.f, 0.f};
#pragma unroll
        for (int ai = 0; ai < 2; ++ai)
#pragma unroll
            for (int m = 0; m < 4; ++m) { const size_t off = (size_t)(wr * 64 + fr + ai * HALF + m * 16) * 1024 + col0;
#pragma unroll
                for (int bj = 0; bj < 2; ++bj)
#pragma unroll
                    for (int n = 0; n < 2; ++n) { const f32x4 x = *(const f32x4*)(rbase + off + bj * HALF + n * 16);
                        *(f32x4*)(obase + off + bj * HALF + n * 16) = x * alpha + acc[ai][bj][m][n] + bv[bj][n]; }
                PG8_ROWFENCE(); }
    }
};

template <class Epi, class Sched, bool ALIGN_EPI = false, bool SP2 = false>
__device__ __forceinline__ void gemm_phase(PG8_LAS unsigned char* lds, const Gemm g, const Sched& S, const Epi& E) {
    int tid_ = threadIdx.x; asm volatile("" : "+v"(tid_));
    const int tid = tid_, wid = __builtin_amdgcn_readfirstlane(tid >> 6), lane = tid & 63, wr = wid >> 2, wc = wid & 3, fr = lane & 15, fq = lane >> 4;
    const int K = g.K, nt = K / BK;
    unsigned voffA[2], voffB[2];
#pragma unroll
    for (int i = 0; i < 2; ++i) { int R, C; stage_rc(tid * 16 + i * 8192, R, C); const int Rb = Epi::PERM ? ((R & ~31) + perm32(R & 31)) : R;
        voffA[i] = (unsigned)(R * g.lda + C) * 2u; voffB[i] = (unsigned)(Rb * g.ldb + C) * 2u; }
    const size_t kstep = (size_t)(BK * 2);
    const size_t hstepA = (size_t)HALF * g.lda * 2, hstepB = (size_t)HALF * g.ldb * 2;
    const size_t tstepA = 2 * hstepA, tstepB = 2 * hstepB;
    const unsigned ldsw = (unsigned)wid * 1024u;
    const int aoff = lds_byte(wr * 64 + fr, fq * 8), boff = lds_byte(wc * 32 + fr, fq * 8);
#define PG8_SA(b, h) (((b) * 2 + (h)) * HTB)
#define PG8_SB(b, h) ((4 + (b) * 2 + (h)) * HTB)
#define PG8_STAGE(bufoff, gbase, voff) do { _Pragma("unroll") for (int _i = 0; _i < 2; ++_i) \
        __builtin_amdgcn_global_load_lds((const unsigned*)((const char*)(gbase) + (voff)[_i]), (PG8_LAS unsigned*)(lds + (bufoff) + ldsw + _i * 8192), 16, 0, 0); } while (0)
#define PG8_LDA(dst, b, h) do { _Pragma("unroll") for (int m = 0; m < 4; ++m) _Pragma("unroll") for (int k = 0; k < 2; ++k) dst[m][k] = *(const PG8_LAS bf16x8*)(lds + PG8_SA(b, h) + aoff + m * 2048 + k * 1024); } while (0)
#define PG8_LDB(dst, b, h) do { _Pragma("unroll") for (int n = 0; n < 2; ++n) _Pragma("unroll") for (int k = 0; k < 2; ++k) dst[n][k] = *(const PG8_LAS bf16x8*)(lds + PG8_SB(b, h) + boff + n * 2048 + k * 1024); } while (0)
#define PG8_MMA(ai, bj, At, Bt) do { __builtin_amdgcn_s_setprio(1); _Pragma("unroll") for (int m = 0; m < 4; ++m) _Pragma("unroll") for (int n = 0; n < 2; ++n) _Pragma("unroll") for (int k = 0; k < 2; ++k) \
        acc[ai][bj][m][n] = __builtin_amdgcn_mfma_f32_16x16x32_bf16(Bt[n][k], At[m][k], acc[ai][bj][m][n], 0, 0, 0); __builtin_amdgcn_s_setprio(0); } while (0)
#define PG8_WAIT_V(n) asm volatile("s_waitcnt vmcnt(" #n ")" ::: "memory")
#define PG8_WAIT_L(n) asm volatile("s_waitcnt lgkmcnt(" #n ")" ::: "memory")
#define PG8_BAR __builtin_amdgcn_s_barrier()
#define PG8_SCHED __builtin_amdgcn_sched_barrier(0)
    Unit cur, nxt; int ui = 0;
    if (!S.next(0, cur)) return;
    f32x4 acc[2][2][4][2];
#pragma unroll
    for (int a = 0; a < 2; ++a)
#pragma unroll
        for (int b = 0; b < 2; ++b)
#pragma unroll
            for (int m = 0; m < 4; ++m)
#pragma unroll
                for (int n = 0; n < 2; ++n) acc[a][b][m][n] = (f32x4){0.f, 0.f, 0.f, 0.f};
    bf16x8 At[4][2], B0[2][2], B1[2][2];
    const char* cA = (const char*)g.A + (size_t)cur.pm * tstepA; const char* cB = (const char*)g.Bt + (size_t)cur.pn * tstepB;
    S.a_ready(cur);
    if constexpr (SP2) {
        PG8_STAGE(PG8_SB(0, 0), cB, voffB); PG8_STAGE(PG8_SB(0, 1), cB + hstepB, voffB); PG8_STAGE(PG8_SA(0, 0), cA, voffA); PG8_STAGE(PG8_SA(0, 1), cA + hstepA, voffA);
        if (wr == 1) PG8_BAR;
        PG8_WAIT_V(2); PG8_BAR;
        PG8_STAGE(PG8_SB(1, 0), cB + kstep, voffB); PG8_STAGE(PG8_SA(1, 0), cA + kstep, voffA); PG8_STAGE(PG8_SB(1, 1), cB + hstepB + kstep, voffB);
        PG8_WAIT_V(6); PG8_BAR;
    } else {
        PG8_STAGE(PG8_SB(0, 0), cB, voffB); PG8_STAGE(PG8_SA(0, 0), cA, voffA); PG8_STAGE(PG8_SB(0, 1), cB + hstepB, voffB); PG8_STAGE(PG8_SA(0, 1), cA + hstepA, voffA);
        if (wr == 1) PG8_BAR;
        PG8_WAIT_V(4); PG8_BAR;
        PG8_STAGE(PG8_SB(1, 0), cB + kstep, voffB); PG8_STAGE(PG8_SA(1, 0), cA + kstep, voffA); PG8_STAGE(PG8_SB(1, 1), cB + hstepB + kstep, voffB);
        PG8_WAIT_V(6); PG8_BAR;
    }
    for (;;) {
        const bool has_next = S.next(ui + 1, nxt);
        const char* nA = has_next ? (const char*)g.A + (size_t)nxt.pm * tstepA : cA; const char* nB = has_next ? (const char*)g.Bt + (size_t)nxt.pn * tstepB : cB;
        for (int t = 0; t < nt; t += 2) {
            const bool last = (t == nt - 2);
            const char* a1 = cA + (size_t)(t + 1) * kstep;
            const char* a2 = last ? nA : cA + (size_t)(t + 2) * kstep; const char* b2 = last ? nB : cB + (size_t)(t + 2) * kstep;
            const char* a3 = a2 + kstep; const char* b3 = b2 + kstep;
            if (last && has_next) S.a_ready(nxt);
            if constexpr (SP2) {
            PG8_LDB(B0, 0, 0); PG8_LDB(B1, 0, 1); PG8_SCHED; PG8_LDA(At, 0, 0); PG8_STAGE(PG8_SA(1, 1), a1 + hstepA, voffA);
            PG8_WAIT_V(8); PG8_WAIT_L(0); PG8_BAR; PG8_MMA(0, 0, At, B0); PG8_MMA(0, 1, At, B1); PG8_BAR; PG8_SCHED;
            PG8_LDA(At, 0, 1); PG8_STAGE(PG8_SB(0, 0), b2, voffB); PG8_STAGE(PG8_SB(0, 1), b2 + hstepB, voffB); PG8_STAGE(PG8_SA(0, 0), a2, voffA);
            PG8_WAIT_V(8); PG8_WAIT_L(0); PG8_BAR; PG8_MMA(1, 0, At, B0); PG8_MMA(1, 1, At, B1); PG8_BAR; PG8_SCHED;
            PG8_LDB(B0, 1, 0); PG8_LDB(B1, 1, 1); PG8_SCHED; PG8_LDA(At, 1, 0); PG8_STAGE(PG8_SA(0, 1), a2 + hstepA, voffA);
            PG8_WAIT_V(8); PG8_WAIT_L(0); PG8_BAR; PG8_MMA(0, 0, At, B0); PG8_MMA(0, 1, At, B1); PG8_BAR; PG8_SCHED;
            PG8_LDA(At, 1, 1); PG8_STAGE(PG8_SB(1, 0), b3, voffB); PG8_STAGE(PG8_SB(1, 1), b3 + hstepB, voffB); PG8_STAGE(PG8_SA(1, 0), a3, voffA);
            PG8_WAIT_V(8); PG8_WAIT_L(0); PG8_BAR; PG8_MMA(1, 0, At, B0); PG8_MMA(1, 1, At, B1); PG8_BAR; PG8_SCHED;
            } else {
            PG8_LDB(B0, 0, 0); PG8_SCHED; PG8_LDA(At, 0, 0); PG8_STAGE(PG8_SA(1, 1), a1 + hstepA, voffA);
            PG8_WAIT_L(8); PG8_BAR; PG8_WAIT_L(0); PG8_MMA(0, 0, At, B0); PG8_BAR; PG8_SCHED;
            PG8_LDB(B1, 0, 1); PG8_STAGE(PG8_SB(0, 0), b2, voffB);
            PG8_BAR; PG8_WAIT_L(0); PG8_MMA(0, 1, At, B1); PG8_BAR;
            PG8_LDA(At, 0, 1); PG8_STAGE(PG8_SA(0, 0), a2, voffA);
            PG8_BAR; PG8_WAIT_L(0); PG8_MMA(1, 0, At, B0); PG8_BAR; PG8_SCHED;
            PG8_STAGE(PG8_SB(0, 1), b2 + hstepB, voffB);
            PG8_WAIT_V(6); PG8_BAR; PG8_MMA(1, 1, At, B1); PG8_BAR;
            PG8_LDB(B0, 1, 0); PG8_SCHED; PG8_LDA(At, 1, 0); PG8_STAGE(PG8_SA(0, 1), a2 + hstepA, voffA);
            PG8_WAIT_L(8); PG8_BAR; PG8_WAIT_L(0); PG8_MMA(0, 0, At, B0); PG8_BAR; PG8_SCHED;
            PG8_LDB(B1, 1, 1); PG8_STAGE(PG8_SB(1, 0), b3, voffB);
            PG8_BAR; PG8_WAIT_L(0); PG8_MMA(0, 1, At, B1); PG8_BAR;
            PG8_LDA(At, 1, 1); PG8_STAGE(PG8_SA(1, 0), a3, voffA);
            PG8_BAR; PG8_WAIT_L(0); PG8_MMA(1, 0, At, B0); PG8_BAR; PG8_SCHED;
            PG8_STAGE(PG8_SB(1, 1), b3 + hstepB, voffB);
            PG8_WAIT_V(6); PG8_BAR; PG8_MMA(1, 1, At, B1); PG8_BAR;
            }
        }
        if constexpr (ALIGN_EPI) { if (wr == 0) PG8_BAR; }
        if constexpr (!Epi::AFTER_DRAIN) { E(acc, cur, wr, wc, fr, fq); S.done(cur); }
        if (!has_next) break;
#pragma unroll
        for (int a = 0; a < 2; ++a)
#pragma unroll
            for (int b = 0; b < 2; ++b)
#pragma unroll
                for (int m = 0; m < 4; ++m)
#pragma unroll
                    for (int n = 0; n < 2; ++n) acc[a][b][m][n] = (f32x4){0.f, 0.f, 0.f, 0.f};
        cur = nxt; cA = nA; cB = nB; ++ui;
        if constexpr (ALIGN_EPI) { if (wr == 1) PG8_BAR; }
    }
    PG8_WAIT_V(0);
    if constexpr (!ALIGN_EPI) { if (wr == 0) PG8_BAR; }
    PG8_BAR;
    if constexpr (Epi::AFTER_DRAIN) { E.fused(acc, cur, wr, wc, fr, fq, lds, wid, lane); S.done(cur); }
#undef PG8_SA
#undef PG8_SB
#undef PG8_STAGE
#undef PG8_LDA
#undef PG8_LDB
#undef PG8_MMA
#undef PG8_WAIT_V
#undef PG8_WAIT_L
#undef PG8_BAR
#undef PG8_SCHED
}
}

namespace att {
#define ATT_LAS __attribute__((address_space(3)))
typedef unsigned short bf16_t;
typedef short bf16x8 __attribute__((ext_vector_type(8)));
typedef short s16x4 __attribute__((ext_vector_type(4)));
typedef float f32x16 __attribute__((ext_vector_type(16)));
typedef unsigned u32x4 __attribute__((ext_vector_type(4)));
typedef unsigned u32x2 __attribute__((ext_vector_type(2)));
typedef ATT_LAS unsigned char* ldsp;
constexpr float LOG2E = 1.4426950408889634f;
constexpr float QSCALE = 0.125f * LOG2E;
constexpr float LN_EPS = 1e-5f;
#define ATT_MFMA(a, b, c) __builtin_amdgcn_mfma_f32_32x32x16_bf16((a), (b), (c), 0, 0, 0)
__device__ __forceinline__ s16x4 vtr(ldsp p) { return __builtin_bit_cast(s16x4, __builtin_amdgcn_ds_read_tr16_b64_v4i16((ATT_LAS s16x4*)p)); }
__device__ __forceinline__ bf16x8 pack_frag(const f32x16& x, int s8) {
    u32x4 p; p.x = pg8::pk_bf16(x[s8], x[s8 + 1]); p.y = pg8::pk_bf16(x[s8 + 2], x[s8 + 3]); p.z = pg8::pk_bf16(x[s8 + 4], x[s8 + 5]); p.w = pg8::pk_bf16(x[s8 + 6], x[s8 + 7]);
    return __builtin_bit_cast(bf16x8, p);
}
__device__ __forceinline__ int voff(int key, int ch  ) { return (ch >> 2) * 4096 + (key >> 4) * 1024 + ((key >> 3) & 1) * 512 + (key & 7) * 64 + (ch & 3) * 16; }

constexpr int DKP = 272;
constexpr int DKBUF = 64 * DKP, DVBUF = 64 * 256, DBUF = DKBUF + DVBUF;
constexpr int DXOFF = 2 * DBUF;
constexpr int D_LDS = DXOFF + 65536;

__device__ __forceinline__ void diff_unit(ldsp lds, const bf16_t* Qp, const bf16_t* Kp, const bf16_t* Vp, bf16_t* Op,
                                          long rowbase, int S, int h, int qblk, float lam, const float* __restrict__ subln_g, const unsigned* stats  ) {
    int tid_ = threadIdx.x; asm volatile("" : "+v"(tid_));
    const int tid = tid_, lane = tid & 63, r = lane & 31, hh = lane >> 5;
    const int wid = __builtin_amdgcn_readfirstlane(tid >> 6), c = wid >> 2, qsub = wid & 3;
    const int q0 = qblk * 128, qpos = q0 + qsub * 32 + r;
    const float nslope2 = -LOG2E * __builtin_amdgcn_exp2f(-(float)(h + 1));
    bf16x8 qf[4];
    { const bf16_t* qptr = Qp + (size_t)(rowbase + qpos) * 1024 + h * 128 + c * 64 + hh * 8;
#pragma unroll
      for (int ks = 0; ks < 4; ++ks) qf[ks] = *(const bf16x8*)(qptr + ks * 16); }
    const int skey = tid >> 4, sch = tid & 15;
    const bf16_t* kg = Kp + (size_t)(rowbase + skey) * 1024 + h * 128 + sch * 8;
    const bf16_t* vg = Vp + (size_t)(rowbase + skey) * 1024 + h * 128 + sch * 8;
    const int NT = S / 64;
    int tlo, thi; bool fast;
    { float b2 = 0.f;
#pragma unroll
      for (int cc = 0; cc < 2; ++cc) { const float qn = __uint_as_float(stats[h * 4 + cc * 2]) + __uint_as_float(stats[h * 4 + cc * 2 + 1]);
          const float kn = __uint_as_float(stats[32 + h * 4 + cc * 2]) + __uint_as_float(stats[32 + h * 4 + cc * 2 + 1]); b2 = fmaxf(b2, qn * kn); }
      const float B = 1.02f * sqrtf(b2); fast = __builtin_amdgcn_readfirstlane((int)(B <= 60.f)) != 0;
      float dcf = (80.f + 2.f * B) / (-nslope2) + 2.f; if (!(dcf < (float)S)) dcf = (float)S;
      const int dc = (int)dcf; const int lo = q0 - dc, hi2 = q0 + 127 + dc;
      tlo = lo <= 0 ? 0 : (lo >> 6); thi = (hi2 >> 6) > NT - 1 ? NT - 1 : (hi2 >> 6);
      tlo = __builtin_amdgcn_readfirstlane(tlo); thi = __builtin_amdgcn_readfirstlane(thi); }
    const int kl0r = skey * DKP + sch * 16, kl1r = (skey + 32) * DKP + sch * 16, vl0r = voff(skey, sch), vl1r = voff(skey + 32, sch);
    float l = 0.f;
    f32x16 o[4];
#pragma unroll
    for (int eb = 0; eb < 4; ++eb)
#pragma unroll
        for (int i = 0; i < 16; ++i) o[eb][i] = 0.f;
    const int kread = r * DKP + c * 128 + hh * 16;
    const int vreadr = (4 * hh + ((lane & 15) >> 2)) * 64 + ((lane >> 4) & 1) * 32 + (lane & 3) * 8;
    if (fast) {
        const float slope2 = -nslope2; const int qw0 = q0 + qsub * 32;
        typedef float f32x2 __attribute__((ext_vector_type(2)));
        constexpr int RK = 0, RV = 65536, RS = 16384;
        const int krow = 4 * wid + (lane >> 4);
        const bf16_t* kgd = Kp + (size_t)(rowbase + krow) * 1024 + h * 128 + (((lane & 15) ^ (krow & 15)) * 8);
        const bf16_t* vgd = Vp + (size_t)(rowbase + 16 * (wid & 3) + (lane >> 2)) * 1024 + h * 128 + ((wid >> 2) * 4 + (lane & 3)) * 8;
#define DF_DMA(g, l) __builtin_amdgcn_global_load_lds((const unsigned*)(g), (ATT_LAS unsigned*)(l), 16, 0, 0)
#define DF_DMAK(tt, slot) do { const bf16_t* g_ = kgd + (size_t)(tt) * 64 * 1024; const ldsp l_ = lds + RK + (slot) * RS + wid * 1024; DF_DMA(g_, l_); DF_DMA(g_ + 32 * 1024, l_ + 8192); } while (0)
#define DF_DMAV(tt, slot) do { const bf16_t* g_ = vgd + (size_t)(tt) * 64 * 1024; const ldsp l_ = lds + RV + (slot) * RS + wid * 1024; DF_DMA(g_, l_); DF_DMA(g_ + 64, l_ + 8192); } while (0)
#define DF_CF(i) ((float)(((i) & 3) + 8 * ((i) >> 2)))
#define DF_INIT(S0, S1, tt) do { const int tb_ = (tt) * 64; const float db_ = (float)(tb_ + 4 * hh - qpos); \
        if (tb_ + 63 < qw0 || tb_ > qw0 + 31) { const float a_ = (tb_ + 63 < qw0) ? slope2 : -slope2, bl_ = (tt) > thi ? -INFINITY : a_ * db_;   \
            _Pragma("unroll") for (int i = 0; i < 16; ++i) { S0[i] = __builtin_fmaf(a_, DF_CF(i), bl_); S1[i] = __builtin_fmaf(a_, DF_CF(i) + 32.f, bl_); } } \
        else { _Pragma("unroll") for (int i = 0; i < 16; ++i) { S0[i] = nslope2 * __builtin_fabsf(db_ + DF_CF(i)); S1[i] = nslope2 * __builtin_fabsf(db_ + DF_CF(i) + 32.f); } } } while (0)
#define DF_VLOAD(ARR, vb, eb) do { _Pragma("unroll") for (int kk = 0; kk < 4; ++kk) { const s16x4 lo_ = vtr((vb) + (eb) * 4096 + kk * 1024), hi_ = vtr((vb) + (eb) * 4096 + kk * 1024 + 512); \
        ARR[kk] = __builtin_shufflevector(lo_, hi_, 0, 1, 2, 3, 4, 5, 6, 7); } } while (0)
#define DF_SB() __builtin_amdgcn_sched_barrier(0)
#define DF_CL(tt) ((tt) < thi ? (tt) : thi)
        f32x2 l2 = {0.f, 0.f};
        const int n = thi - tlo + 1;
        int koff[4];
#pragma unroll
        for (int ks = 0; ks < 4; ++ks) koff[ks] = r * 256 + (((c * 8 + 2 * ks + hh) ^ (r & 15)) << 4);
        DF_DMAK(tlo, 0); DF_DMAV(tlo, 3);
        DF_DMAK(DF_CL(tlo + 1), 1); DF_DMAV(tlo, 0);
        DF_DMAK(DF_CL(tlo + 2), 2); DF_DMAV(DF_CL(tlo + 1), 1);
        f32x16 sa0, sa1, sb0, sb1; bf16x8 pf[4];
#pragma unroll
        for (int i = 0; i < 16; ++i) { sa0[i] = 0.f; sa1[i] = 0.f; }
        const int n2 = n + (n & 1);
#define DF_SGB(mask, cnt) __builtin_amdgcn_sched_group_barrier((mask), (cnt), 0)
#define DF_PIN(x) asm volatile("" : "+v"(x))
#define DF_STEP(SO0, SO1, SN0, SN1, jj) do { \
            const int T_ = tlo + (jj); \
              \
            asm volatile("s_waitcnt vmcnt(8)" ::: "memory"); __builtin_amdgcn_s_barrier(); asm volatile("" ::: "memory"); \
            DF_DMAK(DF_CL(T_ + 3), ((jj) + 3) & 3); DF_DMAV(DF_CL(T_ + 2), ((jj) + 2) & 3); \
            DF_INIT(SN0, SN1, T_); \
            const ldsp kb_ = lds + RK + ((jj) & 3) * RS; \
            const ldsp vb_ = lds + RV + (((jj) + 3) & 3) * RS + vreadr; \
            bf16x8 kf[8], vA[4], vB[4]; \
            _Pragma("unroll") for (int ks = 0; ks < 4; ++ks) { kf[2 * ks] = *(const ATT_LAS bf16x8*)(kb_ + koff[ks]); kf[2 * ks + 1] = *(const ATT_LAS bf16x8*)(kb_ + koff[ks] + 8192); } \
            DF_VLOAD(vA, vb_, 0); \
            DF_SB(); \
              \
            _Pragma("unroll") for (int ks = 0; ks < 4; ++ks) { SN0 = ATT_MFMA(kf[2 * ks], qf[ks], SN0); SN1 = ATT_MFMA(kf[2 * ks + 1], qf[ks], SN1); } \
            _Pragma("unroll") for (int i = 0; i < 8; ++i) { l2 += (f32x2){SO0[2 * i], SO0[2 * i + 1]}; l2 += (f32x2){SO1[2 * i], SO1[2 * i + 1]}; } \
            pf[0] = pack_frag(SO0, 0); pf[1] = pack_frag(SO0, 8); pf[2] = pack_frag(SO1, 0); pf[3] = pack_frag(SO1, 8); \
            DF_VLOAD(vB, vb_, 1); \
            _Pragma("unroll") for (int g_ = 0; g_ < 8; ++g_) { DF_SGB(0x008, 1); DF_SGB(0x100, 1); DF_SGB(0x002, 4); } \
            DF_SB(); \
              \
            _Pragma("unroll") for (int kk = 0; kk < 4; ++kk) o[0] = ATT_MFMA(vA[kk], pf[kk], o[0]); \
            _Pragma("unroll") for (int i = 0; i < 8; ++i) SN0[i] = __builtin_amdgcn_exp2f(SN0[i]); \
            DF_VLOAD(vA, vb_, 2); \
            _Pragma("unroll") for (int g_ = 0; g_ < 4; ++g_) { DF_SGB(0x008, 1); DF_SGB(0x400, 2); DF_SGB(0x100, 2); } \
            DF_PIN(SN0); DF_SB(); \
              \
            _Pragma("unroll") for (int kk = 0; kk < 4; ++kk) o[1] = ATT_MFMA(vB[kk], pf[kk], o[1]); \
            _Pragma("unroll") for (int i = 8; i < 16; ++i) SN0[i] = __builtin_amdgcn_exp2f(SN0[i]); \
            DF_VLOAD(vB, vb_, 3); \
            _Pragma("unroll") for (int g_ = 0; g_ < 4; ++g_) { DF_SGB(0x008, 1); DF_SGB(0x400, 2); DF_SGB(0x100, 2); } \
            DF_PIN(SN0); DF_SB(); \
              \
            _Pragma("unroll") for (int kk = 0; kk < 4; ++kk) o[2] = ATT_MFMA(vA[kk], pf[kk], o[2]); \
            _Pragma("unroll") for (int i = 0; i < 8; ++i) SN1[i] = __builtin_amdgcn_exp2f(SN1[i]); \
            _Pragma("unroll") for (int g_ = 0; g_ < 4; ++g_) { DF_SGB(0x008, 1); DF_SGB(0x400, 2); } \
            DF_PIN(SN1); DF_SB(); \
              \
            _Pragma("unroll") for (int kk = 0; kk < 4; ++kk) o[3] = ATT_MFMA(vB[kk], pf[kk], o[3]); \
            _Pragma("unroll") for (int i = 8; i < 16; ++i) SN1[i] = __builtin_amdgcn_exp2f(SN1[i]); \
            _Pragma("unroll") for (int g_ = 0; g_ < 4; ++g_) { DF_SGB(0x008, 1); DF_SGB(0x400, 2); } \
            DF_PIN(SN1); DF_SB(); \
        } while (0)
        for (int j = 0; j < n2; j += 2) {
            DF_STEP(sa0, sa1, sb0, sb1, j);
            DF_STEP(sb0, sb1, sa0, sa1, j + 1);
        }
#undef DF_STEP
#undef DF_SGB
#undef DF_PIN
        asm volatile("s_waitcnt vmcnt(0)" ::: "memory"); __builtin_amdgcn_s_barrier(); asm volatile("" ::: "memory");
#pragma unroll
        for (int i = 0; i < 8; ++i) { l2 += (f32x2){sa0[2 * i], sa0[2 * i + 1]}; l2 += (f32x2){sa1[2 * i], sa1[2 * i + 1]}; }
        pf[0] = pack_frag(sa0, 0); pf[1] = pack_frag(sa0, 8); pf[2] = pack_frag(sa1, 0); pf[3] = pack_frag(sa1, 8);
        { const ldsp vb_ = lds + RV + ((n2 - 1) & 3) * RS + vreadr;
#pragma unroll
          for (int eb = 0; eb < 4; ++eb)
#pragma unroll
              for (int kk = 0; kk < 4; ++kk) { const s16x4 lo_ = vtr(vb_ + eb * 4096 + kk * 1024), hi_ = vtr(vb_ + eb * 4096 + kk * 1024 + 512);
                  o[eb] = ATT_MFMA(__builtin_shufflevector(lo_, hi_, 0, 1, 2, 3, 4, 5, 6, 7), pf[kk], o[eb]); } }
        l = l2.x + l2.y;
        __syncthreads();
#undef DF_DMA
#undef DF_DMAK
#undef DF_DMAV
#undef DF_CF
#undef DF_INIT
#undef DF_VLOAD
#undef DF_SB
#undef DF_CL
    } else {
    u32x4 sk0, sk1, sv0, sv1;
    const int kl0 = kl0r, kl1 = kl1r, vl0 = DKBUF + vl0r, vl1 = DKBUF + vl1r, vread = DKBUF + vreadr;
    float m = -1e30f;
    { const size_t go = (size_t)tlo * 64 * 1024;
      sk0 = *(const u32x4*)(kg + go); sk1 = *(const u32x4*)(kg + go + 32 * 1024); sv0 = *(const u32x4*)(vg + go); sv1 = *(const u32x4*)(vg + go + 32 * 1024); }
    *(ATT_LAS u32x4*)(lds + kl0) = sk0; *(ATT_LAS u32x4*)(lds + kl1) = sk1; *(ATT_LAS u32x4*)(lds + vl0) = sv0; *(ATT_LAS u32x4*)(lds + vl1) = sv1;
    __syncthreads();
    for (int t = tlo; t <= thi; ++t) {
        const int bsel = (t - tlo) & 1;
        const ldsp cur = lds + bsel * DBUF;
        const bool more = (t < thi);
        if (more) { const size_t go = (size_t)(t + 1) * 64 * 1024;
            sk0 = *(const u32x4*)(kg + go); sk1 = *(const u32x4*)(kg + go + 32 * 1024); sv0 = *(const u32x4*)(vg + go); sv1 = *(const u32x4*)(vg + go + 32 * 1024); }
        f32x16 s0, s1;
#pragma unroll
        for (int i = 0; i < 16; ++i) { s0[i] = 0.f; s1[i] = 0.f; }
#pragma unroll
        for (int ks = 0; ks < 4; ++ks) {
            const bf16x8 k0 = *(const ATT_LAS bf16x8*)(cur + kread + ks * 32);
            const bf16x8 k1 = *(const ATT_LAS bf16x8*)(cur + kread + 32 * DKP + ks * 32);
            s0 = ATT_MFMA(k0, qf[ks], s0); s1 = ATT_MFMA(k1, qf[ks], s1);
        }
        const float dbase = (float)(t * 64 + 4 * hh - qpos);
        float mx = -1e30f;
#pragma unroll
        for (int i = 0; i < 16; ++i) { const float d0 = dbase + (float)((i & 3) + 8 * (i >> 2));
            s0[i] = __builtin_fmaf(nslope2, __builtin_fabsf(d0), s0[i]); s1[i] = __builtin_fmaf(nslope2, __builtin_fabsf(d0 + 32.f), s1[i]);
            mx = fmaxf(mx, fmaxf(s0[i], s1[i])); }
        mx = fmaxf(mx, __shfl_xor(mx, 32));
        if (__any(mx > m)) { const float mn = fmaxf(m, mx), al = __builtin_amdgcn_exp2f(m - mn); m = mn; l *= al;
#pragma unroll
            for (int eb = 0; eb < 4; ++eb) o[eb] *= al; }
        float rs = 0.f;
#pragma unroll
        for (int i = 0; i < 16; ++i) { s0[i] = __builtin_amdgcn_exp2f(s0[i] - m); s1[i] = __builtin_amdgcn_exp2f(s1[i] - m); rs += s0[i] + s1[i]; }
        l += rs;
        bf16x8 pf[4]; pf[0] = pack_frag(s0, 0); pf[1] = pack_frag(s0, 8); pf[2] = pack_frag(s1, 0); pf[3] = pack_frag(s1, 8);
#pragma unroll
        for (int eb = 0; eb < 4; ++eb)
#pragma unroll
            for (int kk = 0; kk < 4; ++kk) {
                const s16x4 lo = vtr(cur + vread + eb * 4096 + kk * 1024), hi = vtr(cur + vread + eb * 4096 + kk * 1024 + 512);
                const bf16x8 vf = __builtin_shufflevector(lo, hi, 0, 1, 2, 3, 4, 5, 6, 7);
                o[eb] = ATT_MFMA(vf, pf[kk], o[eb]);
            }
        if (more) { const ldsp nx = lds + (bsel ^ 1) * DBUF;
            *(ATT_LAS u32x4*)(nx + kl0) = sk0; *(ATT_LAS u32x4*)(nx + kl1) = sk1; *(ATT_LAS u32x4*)(nx + vl0) = sv0; *(ATT_LAS u32x4*)(nx + vl1) = sv1; }
        __syncthreads();
    }
    }
    l += __shfl_xor(l, 32);
    const float inv = 1.f / l;
    ATT_LAS float* X = (ATT_LAS float*)(lds + DXOFF) + qsub * 4096 + lane;
    if (c == 1) {
#pragma unroll
        for (int eb = 0; eb < 4; ++eb)
#pragma unroll
            for (int i = 0; i < 16; ++i) X[(eb * 16 + i) * 64] = o[eb][i] * inv;
    }
    __syncthreads();
    if (c == 0) {
        float ss = 0.f;
#pragma unroll
        for (int eb = 0; eb < 4; ++eb)
#pragma unroll
            for (int i = 0; i < 16; ++i) { const float v = o[eb][i] * inv - lam * X[(eb * 16 + i) * 64]; o[eb][i] = v; ss += v * v; }
        ss += __shfl_xor(ss, 32);
        const float rn = 0.8f * __builtin_amdgcn_rsqf(ss * (1.f / 128.f) + LN_EPS);
        bf16_t* orow = Op + (size_t)(rowbase + qpos) * 1024 + h * 128 + 4 * hh;
#pragma unroll
        for (int eb = 0; eb < 4; ++eb)
#pragma unroll
            for (int g4 = 0; g4 < 4; ++g4) { const int e0 = eb * 32 + 8 * g4;
                const float4 gv = *(const float4*)(subln_g + e0 + 4 * hh);
                u32x2 w; w.x = pg8::pk_bf16(o[eb][4 * g4] * rn * gv.x, o[eb][4 * g4 + 1] * rn * gv.y); w.y = pg8::pk_bf16(o[eb][4 * g4 + 2] * rn * gv.z, o[eb][4 * g4 + 3] * rn * gv.w);
                *(u32x2*)(orow + e0) = w; }
    }
    __syncthreads();
}

constexpr int WKP = 144;
constexpr int WKBUF = 64 * WKP, WVBUF = 64 * 128, WBUF = WKBUF + WVBUF;

__device__ __forceinline__ void win_unit(ldsp lds, const bf16_t* Qp, const bf16_t* Kp, const bf16_t* Vp, bf16_t* Op,
                                         long rowbase, int S, int g, int qblk, const float* __restrict__ sink) {
    int tid_ = threadIdx.x; asm volatile("" : "+v"(tid_));
    const int tid = tid_, lane = tid & 63, r = lane & 31, hh = lane >> 5;
    const int wid = __builtin_amdgcn_readfirstlane(tid >> 6), hq = g * 4 + (wid & 3);
    const int q0 = qblk * 64, qw0 = q0 + (wid >> 2) * 32, qpos = qw0 + r;
    const float nslope2 = -LOG2E * __builtin_amdgcn_exp2f(-0.5f * (float)(hq + 1));
    bf16x8 qf[4];
    { const bf16_t* qptr = Qp + (size_t)(rowbase + qpos) * 1024 + hq * 64 + hh * 8;
#pragma unroll
      for (int ks = 0; ks < 4; ++ks) qf[ks] = *(const bf16x8*)(qptr + ks * 16); }
    const int skey = tid >> 3, sch = tid & 7;
    const bf16_t* kg = Kp + (size_t)(rowbase + skey) * 256 + g * 64 + sch * 8;
    const bf16_t* vg = Vp + (size_t)(rowbase + skey) * 256 + g * 64 + sch * 8;
    const int kl = skey * WKP + sch * 16, vl = WKBUF + voff(skey, sch);
    const int NT = S / 64;
    int tlo = q0 / 64 - 2; if (tlo < 0) tlo = 0;
    int thi = q0 / 64 + 2; if (thi > NT - 1) thi = NT - 1;
    u32x4 sk, sv;
    sk = *(const u32x4*)(kg + (size_t)tlo * 64 * 256); sv = *(const u32x4*)(vg + (size_t)tlo * 64 * 256);
    *(ATT_LAS u32x4*)(lds + kl) = sk; *(ATT_LAS u32x4*)(lds + vl) = sv;
    __syncthreads();
    float m = -1e30f, l = 0.f;
    f32x16 o[2];
#pragma unroll
    for (int eb = 0; eb < 2; ++eb)
#pragma unroll
        for (int i = 0; i < 16; ++i) o[eb][i] = 0.f;
    const int kread = r * WKP + hh * 16;
    const int vread = WKBUF + (4 * hh + ((lane & 15) >> 2)) * 64 + ((lane >> 4) & 1) * 32 + (lane & 3) * 8;
    for (int t = tlo; t <= thi; ++t) {
        const int b = (t - tlo) & 1;
        const ldsp cur = lds + b * WBUF;
        const bool more = (t < thi);
        if (more) { const size_t go = (size_t)(t + 1) * 64 * 256; sk = *(const u32x4*)(kg + go); sv = *(const u32x4*)(vg + go); }
        const bool active = (t * 64 + 63 >= qw0 - 128) && (t * 64 <= qw0 + 31 + 128);
        if (active) {
            f32x16 s0, s1;
#pragma unroll
            for (int i = 0; i < 16; ++i) { s0[i] = 0.f; s1[i] = 0.f; }
#pragma unroll
            for (int ks = 0; ks < 4; ++ks) {
                const bf16x8 k0 = *(const ATT_LAS bf16x8*)(cur + kread + ks * 32);
                const bf16x8 k1 = *(const ATT_LAS bf16x8*)(cur + kread + 32 * WKP + ks * 32);
                s0 = ATT_MFMA(k0, qf[ks], s0); s1 = ATT_MFMA(k1, qf[ks], s1);
            }
            const float dbase = (float)(t * 64 + 4 * hh - qpos);
            float mx = -INFINITY;
#pragma unroll
            for (int i = 0; i < 16; ++i) { const float d0 = __builtin_fabsf(dbase + (float)((i & 3) + 8 * (i >> 2))), d1 = __builtin_fabsf(dbase + (float)(32 + (i & 3) + 8 * (i >> 2)));
                s0[i] = d0 <= 128.f ? __builtin_fmaf(nslope2, d0, s0[i]) : -INFINITY; s1[i] = d1 <= 128.f ? __builtin_fmaf(nslope2, d1, s1[i]) : -INFINITY;
                mx = fmaxf(mx, fmaxf(s0[i], s1[i])); }
            mx = fmaxf(mx, __shfl_xor(mx, 32));
            if (__any(mx > m)) { const float mn = fmaxf(m, mx), al = __builtin_amdgcn_exp2f(m - mn); m = mn; l *= al;
#pragma unroll
                for (int eb = 0; eb < 2; ++eb) o[eb] *= al; }
            float rs = 0.f;
#pragma unroll
            for (int i = 0; i < 16; ++i) { s0[i] = __builtin_amdgcn_exp2f(s0[i] - m); s1[i] = __builtin_amdgcn_exp2f(s1[i] - m); rs += s0[i] + s1[i]; }
            l += rs;
            bf16x8 pf[4]; pf[0] = pack_frag(s0, 0); pf[1] = pack_frag(s0, 8); pf[2] = pack_frag(s1, 0); pf[3] = pack_frag(s1, 8);
#pragma unroll
            for (int eb = 0; eb < 2; ++eb)
#pragma unroll
                for (int kk = 0; kk < 4; ++kk) {
                    const s16x4 lo = vtr(cur + vread + eb * 4096 + kk * 1024), hi = vtr(cur + vread + eb * 4096 + kk * 1024 + 512);
                    const bf16x8 vf = __builtin_shufflevector(lo, hi, 0, 1, 2, 3, 4, 5, 6, 7);
                    o[eb] = ATT_MFMA(vf, pf[kk], o[eb]);
                }
        }
        if (more) { const ldsp nx = lds + (b ^ 1) * WBUF; *(ATT_LAS u32x4*)(nx + kl) = sk; *(ATT_LAS u32x4*)(nx + vl) = sv; }
        __syncthreads();
    }
    l += __shfl_xor(l, 32);
    const float sk2 = sink[hq] * LOG2E, mf = fmaxf(m, sk2), sc = __builtin_amdgcn_exp2f(m - mf);
    const float inv = sc / (l * sc + __builtin_amdgcn_exp2f(sk2 - mf));
    bf16_t* orow = Op + (size_t)(rowbase + qpos) * 1024 + hq * 64 + 4 * hh;
#pragma unroll
    for (int eb = 0; eb < 2; ++eb)
#pragma unroll
        for (int g4 = 0; g4 < 4; ++g4) { const int e0 = eb * 32 + 8 * g4;
            u32x2 w; w.x = pg8::pk_bf16(o[eb][4 * g4] * inv, o[eb][4 * g4 + 1] * inv); w.y = pg8::pk_bf16(o[eb][4 * g4 + 2] * inv, o[eb][4 * g4 + 3] * inv);
            *(u32x2*)(orow + e0) = w; }
}
}

#define LAS __attribute__((address_space(3)))
typedef unsigned short bf16;
typedef unsigned v4u __attribute__((ext_vector_type(4)));
typedef float f32x4 __attribute__((ext_vector_type(4)));
constexpr int NWAVES = 8;
constexpr int T_P = 8 * 8192, T_S = 2 * 16384, T_ALL = T_P + T_S;
constexpr int DM = 1024, DFF = 4096, IN_COLS = 6656, QKV_COLS = 4608, GATE_COLS = 2048;
constexpr float DN_ALPHA = 1.189207115002721f;
constexpr float LN_EPS = 1e-5f;
constexpr int LDS_BYTES = 147456;
static_assert(att::D_LDS <= LDS_BYTES && pg8::STAGE_BYTES <= LDS_BYTES, "LDS map");
constexpr size_t WS_WIN = 0;
constexpr size_t WS_WBRA = WS_WIN + (size_t)IN_COLS * DM * 2;
constexpr size_t WS_WBRB = WS_WBRA + (size_t)DM * DM * 2;
constexpr size_t WS_WOUT = WS_WBRB + (size_t)DM * DM * 2;
constexpr size_t WS_WFF1 = WS_WOUT + (size_t)DM * DM * 2;
constexpr size_t WS_WFF2 = WS_WFF1 + (size_t)DFF * DM * 2;
constexpr size_t WS_BIG = WS_WFF2 + (size_t)DFF * DM * 2;
constexpr size_t PLANE = (size_t)T_ALL * DM * 2;
constexpr size_t WS_PA = WS_BIG, WS_PB = WS_PA + PLANE, WS_PC = WS_PB + PLANE, WS_PD = WS_PC + PLANE;
constexpr size_t WS_TAIL = WS_PD + PLANE;
constexpr size_t WS_PE = WS_TAIL, WS_PF = WS_PE + (size_t)T_ALL * 256 * 2;
constexpr size_t WS_CTL = WS_TAIL + PLANE;
constexpr size_t WS_END = WS_CTL + 8192 + 16384;
constexpr int LDS_CTL = 135168;
static_assert(att::D_LDS <= LDS_CTL && LDS_CTL + 16 <= 147456, "LDS ctl word");

__device__ __forceinline__ unsigned f2bf(float f) { unsigned u = __builtin_bit_cast(unsigned, f); return (u + 0x7fffu + ((u >> 16) & 1u)) >> 16; }
__device__ __forceinline__ unsigned pk2(float lo, float hi) { return f2bf(lo) | (f2bf(hi) << 16); }
__device__ __forceinline__ float wave_sum(float v) {
#pragma unroll
    for (int o = 1; o < 64; o <<= 1) v += __shfl_xor(v, o);
    return v;
}
__device__ __forceinline__ void p0_transpose_item(const float* W, int K, int N, bf16* WT, LAS float* scr, int item, int lane) {
    const int nblk = N / 32, kb = item / nblk, nb = item % nblk, k0 = 64 * kb, n0 = 32 * nb;
#pragma unroll 8
    for (int i = 0; i < 32; ++i) { const int kk = 2 * i + (lane >> 5); scr[kk * 33 + (lane & 31)] = W[(size_t)(k0 + kk) * N + n0 + (lane & 31)]; }
    asm volatile("s_waitcnt lgkmcnt(0)" ::: "memory");
    const int c = lane & 7;
#pragma unroll
    for (int j = 0; j < 4; ++j) { const int n = (lane >> 3) + 8 * j; const LAS float* s = scr + (8 * c) * 33 + n;
        v4u o; o.x = pk2(s[0 * 33], s[1 * 33]); o.y = pk2(s[2 * 33], s[3 * 33]); o.z = pk2(s[4 * 33], s[5 * 33]); o.w = pk2(s[6 * 33], s[7 * 33]);
        *(v4u*)(WT + (size_t)(n0 + n) * K + k0 + 8 * c) = o; }
    asm volatile("s_waitcnt lgkmcnt(0)" ::: "memory");
}
template <bool WITH_BF16> __device__ __forceinline__ void ln_rows(float* Z, bf16* Zb, const float* __restrict__ gam, const float* __restrict__ bet, int gw, int NGW, int lane) {
    f32x4 gv[4], bv[4];
#pragma unroll
    for (int j = 0; j < 4; ++j) { gv[j] = *((const f32x4*)gam + 64 * j + lane); bv[j] = *((const f32x4*)bet + 64 * j + lane); }
    for (int m = gw; m < T_ALL; m += NGW) {
        f32x4* zr = (f32x4*)(Z + (size_t)m * DM) + lane;
        f32x4 v[4]; float s = 0.f;
#pragma unroll
        for (int j = 0; j < 4; ++j) { v[j] = zr[64 * j]; s += (v[j].x + v[j].y) + (v[j].z + v[j].w); }
        const float mean = wave_sum(s) * (1.f / DM); float s2 = 0.f;
#pragma unroll
        for (int j = 0; j < 4; ++j) { v[j] = v[j] - mean; s2 += (v[j].x * v[j].x + v[j].y * v[j].y) + (v[j].z * v[j].z + v[j].w * v[j].w); }
        const float rstd = 1.f / sqrtf(wave_sum(s2) * (1.f / DM) + LN_EPS);
#pragma unroll
        for (int j = 0; j < 4; ++j) { const f32x4 y = v[j] * rstd * gv[j] + bv[j]; zr[64 * j] = y;
            if (WITH_BF16) { unsigned long long* o8 = (unsigned long long*)(Zb + (size_t)m * DM) + lane;
                o8[64 * j] = (unsigned long long)pk2(y.x, y.y) | ((unsigned long long)pk2(y.z, y.w) << 32); } }
    }
}

#define XB_TMO      128
#define XB_XCNT(j)  (256  + 64 * (j))
#define XB_XSUB(j)  (1280 + 64 * (j))
#define XB_XGEN(j)  (2304 + 64 * (j))
#define XB_TOP      3328
#define XB_TOPGEN   3392
#define XCD_BAR_WORDS 3456
#define XB_SPIN_CAP (1u << 18)

__device__ __forceinline__ unsigned xb_ld(unsigned* p)              { return __hip_atomic_load(p, __ATOMIC_RELAXED, __HIP_MEMORY_SCOPE_AGENT); }
__device__ __forceinline__ unsigned xb_add(unsigned* p, unsigned v) { return __hip_atomic_fetch_add(p, v, __ATOMIC_RELAXED, __HIP_MEMORY_SCOPE_AGENT); }
__device__ __forceinline__ unsigned xb_xcc_id() { return (unsigned)__builtin_amdgcn_s_getreg((3 << 11) | 20) & 0xFu; }
#define XB_SPIN(cond, bar) do { unsigned _sp = 0; while (cond) { __builtin_amdgcn_s_sleep(1); \
    if ((++_sp & 255u) == 0u) { if (xb_ld(&(bar)[XB_TMO])) break; if (_sp > XB_SPIN_CAP) { atomicAdd(&(bar)[XB_TMO], 1u); break; } } } } while (0)

struct XcdBarrier {
    unsigned* bar; unsigned x;
    volatile LAS unsigned* st;
};

__device__ __forceinline__ XcdBarrier xcd_barrier_post(unsigned* bar, volatile LAS unsigned* st) {
    XcdBarrier b; b.bar = bar; b.x = xb_xcc_id(); b.st = st;
    if (threadIdx.x == 0) (void)xb_add(&bar[XB_XCNT(b.x)], 1u);
    return b;
}
__device__ __forceinline__ void xcd_barrier_complete(unsigned* bar, unsigned x, unsigned& nloc, unsigned& nx) {
    const unsigned G = gridDim.x * gridDim.y * gridDim.z;
    unsigned sum, cnt, mine, sp = 0u;
    for (;;) {
        sum = 0u; cnt = 0u; mine = 0u;
#pragma unroll
        for (unsigned j = 0; j < 16; ++j) { const unsigned c = xb_ld(&bar[XB_XCNT(j)]); sum += c; cnt += (c > 0u) ? 1u : 0u; mine = (j == x) ? c : mine; }
        if (sum == G) break;
        __builtin_amdgcn_s_sleep(1);
        if ((++sp & 255u) == 0u) { if (xb_ld(&bar[XB_TMO])) break; if (sp > XB_SPIN_CAP) { atomicAdd(&bar[XB_TMO], 1u); break; } }
    }
    nloc = mine > 0u ? mine : 1u; nx = cnt > 0u ? cnt : 1u;
}

__device__ __forceinline__ void xcd_barrier(const XcdBarrier& b) {
    asm volatile("s_waitcnt vmcnt(0)" ::: "memory");
    __syncthreads();
    if (threadIdx.x == 0) {
        unsigned* bar = b.bar;
        __builtin_amdgcn_s_waitcnt(0);
        unsigned nloc = b.st[0], nx = b.st[1];
        if (nloc == 0u) { xcd_barrier_complete(bar, b.x, nloc, nx); b.st[0] = nloc; b.st[1] = nx; }
        const unsigned old = xb_add(&bar[XB_XSUB(b.x)], 1u);
        const unsigned gen = old / nloc;
        if (old + 1u == (gen + 1u) * nloc) {
            __builtin_amdgcn_fence(__ATOMIC_RELEASE, "agent");
            asm volatile("s_waitcnt vmcnt(0)" ::: "memory");
            const unsigned og = xb_add(&bar[XB_TOP], 1u);
            const unsigned tg = og / nx;
            if (og + 1u == (tg + 1u) * nx) xb_add(&bar[XB_TOPGEN], 1u);
            else XB_SPIN(xb_ld(&bar[XB_TOPGEN]) == tg, bar);
            __builtin_amdgcn_fence(__ATOMIC_ACQUIRE, "agent");
            xb_add(&bar[XB_XGEN(b.x)], 1u);
            asm volatile("s_waitcnt vmcnt(0)" ::: "memory");
        } else {
            XB_SPIN(xb_ld(&bar[XB_XGEN(b.x)]) == gen, bar);
            __builtin_amdgcn_fence(__ATOMIC_ACQUIRE, "agent");
            asm volatile("s_waitcnt vmcnt(0)" ::: "memory");
        }
    }
    __syncthreads();
}

struct Args { const float* in[21]; float* out; unsigned char* ws; };

__global__ void __launch_bounds__(NWAVES * 64) fwd_megakernel(Args a) {
    extern __shared__ __attribute__((aligned(16))) unsigned char lds_raw[];
    cg::grid_group grid = cg::this_grid();
    LAS unsigned char* lds = (LAS unsigned char*)lds_raw;
    const int tid = threadIdx.x, lane = tid & 63, wave = __builtin_amdgcn_readfirstlane(tid >> 6);
    const int G = gridDim.x, bx = blockIdx.x;
    const int vcu = (G % 8 == 0) ? (bx % 8) * (G / 8) + bx / 8 : bx;
    const int gw = vcu * NWAVES + wave, NGW = G * NWAVES;
    unsigned char* ws = a.ws;
    if (tid < 2) ((volatile LAS unsigned*)(lds + LDS_CTL + 16))[tid] = 0u;
    __syncthreads();
    bf16* WinT = (bf16*)(ws + WS_WIN); bf16* WbraT = (bf16*)(ws + WS_WBRA); bf16* WbrbT = (bf16*)(ws + WS_WBRB); bf16* WoutT = (bf16*)(ws + WS_WOUT);
    bf16* Wff1T = (bf16*)(ws + WS_WFF1); bf16* Wff2T = (bf16*)(ws + WS_WFF2);
    bf16* PA = (bf16*)(ws + WS_PA); bf16* PB = (bf16*)(ws + WS_PB); bf16* PC = (bf16*)(ws + WS_PC); bf16* PD = (bf16*)(ws + WS_PD);
    bf16* PE = (bf16*)(ws + WS_PE); bf16* PF = (bf16*)(ws + WS_PF);
    bf16* GM = PB;
    bf16* HB = PA;
    bf16* X1B = (bf16*)(ws + WS_TAIL);
    bf16* XB = (bf16*)a.out;
    float* OUT = a.out;

    unsigned* ctl = (unsigned*)(ws + WS_CTL);
    {
        if (bx == 0) for (int i = tid; i < 2048 + XCD_BAR_WORDS; i += NWAVES * 64) ctl[i] = 0u;
        LAS float* scr = (LAS float*)(lds + wave * 16384);
        constexpr int I_IN = (DM / 64) * (IN_COLS / 32), I_SQ = (DM / 64) * (DM / 32), I_F1 = (DM / 64) * (DFF / 32), I_F2 = (DFF / 64) * (DM / 32);
        constexpr int NITEMS = I_IN + 3 * I_SQ + I_F1 + I_F2;
        for (int it = gw; it < NITEMS; it += NGW) {
            int r = it;
            if (r < I_IN) { p0_transpose_item(a.in[2], DM, IN_COLS, WinT, scr, r, lane); continue; } r -= I_IN;
            if (r < I_SQ) { p0_transpose_item(a.in[10], DM, DM, WbraT, scr, r, lane); continue; } r -= I_SQ;
            if (r < I_SQ) { p0_transpose_item(a.in[11], DM, DM, WbrbT, scr, r, lane); continue; } r -= I_SQ;
            if (r < I_SQ) { p0_transpose_item(a.in[12], DM, DM, WoutT, scr, r, lane); continue; } r -= I_SQ;
            if (r < I_F1) { p0_transpose_item(a.in[15], DM, DFF, Wff1T, scr, r, lane); continue; } r -= I_F1;
            p0_transpose_item(a.in[17], DFF, DM, Wff2T, scr, r, lane);
        }
        const size_t n8 = (size_t)T_ALL * DM / 8, np8 = (size_t)T_P * DM / 8;
        for (size_t i = (size_t)vcu * (NWAVES * 64) + tid; i < n8; i += (size_t)G * (NWAVES * 64)) {
            const float* src = i < np8 ? a.in[0] + i * 8 : a.in[1] + (i - np8) * 8;
            const f32x4 v0 = *(const f32x4*)src, v1 = *(const f32x4*)(src + 4);
            v4u o; o.x = pk2(v0.x, v0.y); o.y = pk2(v0.z, v0.w); o.z = pk2(v1.x, v1.y); o.w = pk2(v1.z, v1.w);
            *(v4u*)(XB + i * 8) = o;
        }
    }
    grid.sync();
    const XcdBarrier xbar = xcd_barrier_post(ctl + 2048, (volatile LAS unsigned*)(lds + LDS_CTL + 16));

    {
        pg8::Gemm g{XB, WinT, T_ALL, QKV_COLS, DM, DM, DM}; pg8::StaticOrder S; S.init(T_ALL, QKV_COLS, G, bx);
        pg8::EpiQKV E{PA, PB, PC, PD, PE, PF, att::QSCALE, ctl};
        pg8::gemm_phase<pg8::EpiQKV, pg8::StaticOrder, true, true>(lds, g, S, E);
    }
    xcd_barrier(xbar);

    {
        float s1 = 0.f, s2 = 0.f;
        for (int i = 0; i < 64; ++i) { s1 += a.in[4][i] * a.in[5][i]; s2 += a.in[6][i] * a.in[7][i]; }
        const float lam = __expf(s1) - __expf(s2) + 0.2f;
        volatile LAS int* bcast = (volatile LAS int*)(lds + LDS_CTL);
        for (int qi = 0; qi < 8; ++qi) {
            const int x = (bx + qi) & 7;
            for (;;) {
                if (tid == 0) bcast[0] = (int)atomicAdd(ctl + 1024 + 64 * x, 1u);
                __syncthreads();
                const int i = __builtin_amdgcn_readfirstlane(bcast[0]);
                __syncthreads();
                if (i >= 768) break;
                const int si = i >> 5, w = i & 31, gi = si / 3, j = si - 3 * gi, h = 7 - gi, cs = (x + h) & 7;
                if (j == 0) { const int b = cs >> 2, part = cs & 3;
                    att::diff_unit(lds, PA, PB, PC, PA, (long)T_P + (long)b * 16384, 16384, h, part * 32 + w, lam, a.in[8], ctl + (8 + b) * 64); }
                else { const int cp = cs + 8 * (j - 1), b = cp >> 1, part = cp & 1;
                    att::diff_unit(lds, PA, PB, PC, PA, (long)b * 8192, 8192, h, part * 32 + w, lam, a.in[8], ctl + b * 64); }
            }
        }
        for (int it = vcu; it < 6144; it += G) {
            if (it < 4096) { const int b = it / (4 * 128), g = (it / 128) % 4, qb = it % 128;
                att::win_unit(lds, PD, PE, PF, PD, (long)b * 8192, 8192, g, qb, a.in[9]); }
            else { const int i2 = it - 4096; const int b = i2 / (4 * 256), g = (i2 / 256) % 4, qb = i2 % 256;
                att::win_unit(lds, PD, PE, PF, PD, (long)T_P + (long)b * 16384, 16384, g, qb, a.in[9]); }
        }
    }
    xcd_barrier(xbar);

    {
        pg8::Gemm g{XB, WinT + (size_t)QKV_COLS * DM, T_ALL, GATE_COLS, DM, DM, DM}; pg8::StaticOrder S; S.init(T_ALL, GATE_COLS, G, bx);
        pg8::EpiGate E{GM, a.in[3]};
        pg8::gemm_phase<pg8::EpiGate, pg8::StaticOrder, true, true>(lds, g, S, E);
    }
    xcd_barrier(xbar);

    {
        pg8::Gemm g{PA, WbraT, T_ALL, DM, DM, DM, DM}; pg8::StaticOrder S; S.init(T_ALL, DM, G, bx);
        pg8::EpiBranch<false> E{GM};
        pg8::gemm_phase<pg8::EpiBranch<false>, pg8::StaticOrder, true, true>(lds, g, S, E);
    }
    __syncthreads();
    {
        pg8::Gemm g{PD, WbrbT, T_ALL, DM, DM, DM, DM}; pg8::StaticOrder S; S.init(T_ALL, DM, G, bx);
        pg8::EpiBranch<true> E{GM};
        pg8::gemm_phase<pg8::EpiBranch<true>, pg8::StaticOrder, true, true>(lds, g, S, E);
    }
    xcd_barrier(xbar);

    {
        pg8::Gemm g{GM, WoutT, T_ALL, DM, DM, 2048, DM}; pg8::StaticOrder S; S.init(T_ALL, DM, G, bx);
        pg8::EpiRes E{a.in[0], a.in[1], T_P, OUT, nullptr, DN_ALPHA};
        pg8::gemm_phase<pg8::EpiRes, pg8::StaticOrder, true, true>(lds, g, S, E);
    }
    xcd_barrier(xbar);

    ln_rows<true>(OUT, X1B, a.in[13], a.in[14], gw, NGW, lane);
    xcd_barrier(xbar);

    {
        pg8::Gemm g{X1B, Wff1T, T_ALL, DFF, DM, DM, DM}; pg8::StaticOrder S; S.init(T_ALL, DFF, G, bx);
        pg8::EpiFF1 E{HB, a.in[16]};
        pg8::gemm_phase<pg8::EpiFF1, pg8::StaticOrder, true, true>(lds, g, S, E);
    }
    xcd_barrier(xbar);

    {
        pg8::Gemm g{HB, Wff2T, T_ALL, DM, DFF, DFF, DFF}; pg8::StaticOrder S; S.init(T_ALL, DM, G, bx);
        pg8::EpiRes E{OUT, OUT, 1 << 30, OUT, a.in[18], DN_ALPHA};
        pg8::gemm_phase<pg8::EpiRes, pg8::StaticOrder, true, true>(lds, g, S, E);
    }
    xcd_barrier(xbar);

    ln_rows<false>(OUT, nullptr, a.in[19], a.in[20], gw, NGW, lane);
}

extern "C" void kernel_launch(void* const* d_in, const int* in_sizes, int n_in, void* d_out, int out_size, void* d_ws, size_t ws_size, hipStream_t stream) {
    static int grid = 0;
    if (grid == 0) {
        if (n_in != 21 || out_size != T_ALL * DM || ws_size < WS_END) { fprintf(stderr, "kernel_launch: unexpected shapes (n_in %d, out %d, ws %zu < %zu)\n", n_in, out_size, ws_size, (size_t)WS_END); grid = -1; return; }
        int dev = 0, cus = 0, per_cu = 0;
        (void)hipGetDevice(&dev);
        (void)hipDeviceGetAttribute(&cus, hipDeviceAttributeMultiprocessorCount, dev);
        (void)hipFuncSetAttribute((const void*)fwd_megakernel, hipFuncAttributeMaxDynamicSharedMemorySize, LDS_BYTES);
        if (hipOccupancyMaxActiveBlocksPerMultiprocessor(&per_cu, (const void*)fwd_megakernel, NWAVES * 64, LDS_BYTES) != hipSuccess || per_cu < 1) per_cu = 1;
        (void)hipGetLastError();
        if (cus <= 0) cus = 256;
        grid = cus * per_cu;
    }
    if (grid < 0) return;
    Args a{};
    for (int i = 0; i < 21; ++i) a.in[i] = (const float*)d_in[i];
    a.out = (float*)d_out; a.ws = (unsigned char*)d_ws;
    void* args[] = {&a};
    hipError_t e = hipLaunchCooperativeKernel((const void*)fwd_megakernel, dim3(grid), dim3(NWAVES * 64), args, LDS_BYTES, stream);
    if (e != hipSuccess) fprintf(stderr, "cooperative launch failed: %s (grid %d)\n", hipGetErrorString(e), grid);
}
```
